# Optimizing an MI355X kernel written in HIP

```python
import math
import jax, jax.numpy as jnp
from jax import lax
import numpy as np

D_MODEL = 1024
BATCH = 8
SEQ = 4096
DEPTH = 2

HEAD_DIM = 64
A_HEADS = 4
A_VDIM = 2 * HEAD_DIM
B_HEADS = 8
B_BRANCHES = ((128, 1), (512, 4), (2048, 16))
B_BLOCK = 128
C_HEADS = 16
C_Q_RANK = 384
C_KV_RANK = 256
C_NOPE = 64
C_ROPE = 32
C_VDIM = 64
C_SCALE = (C_NOPE + C_ROPE) ** -0.5
IDX_HEADS = 8
IDX_DIM = 64
IDX_ROPE = 32
TOPK_MAX = 256
Q_BLOCK = 128
D_FF = 4 * D_MODEL
PLE_DIM = 256
ROPE_THETA = 10000.0
EPS = 1e-6
N_EVEN = (DEPTH + 1) // 2
N_ODD = DEPTH // 2
AB_SPLITS = (A_HEADS * 2 * HEAD_DIM, A_HEADS * 2 * HEAD_DIM, A_HEADS * A_VDIM,
             B_HEADS * HEAD_DIM, B_HEADS * HEAD_DIM, B_HEADS * HEAD_DIM)
AB_IN = sum(AB_SPLITS)
AB_OUT = A_HEADS * A_VDIM + B_HEADS * HEAD_DIM
C_SPLITS = (C_Q_RANK, C_KV_RANK, C_ROPE, IDX_DIM, IDX_HEADS)
C_IN = sum(C_SPLITS)
C_OUT = C_HEADS * C_VDIM

kernel_name = "hybrid_diff_dilated_dsa_trunk"

F32 = jnp.float32


def rms(x, g):
    xf = x.astype(F32)
    y = xf * lax.rsqrt(jnp.mean(xf * xf, axis=-1, keepdims=True) + EPS) * g.astype(F32)
    return y.astype(x.dtype)


def rope(x, pos):
    half = x.shape[-1] // 2
    inv = ROPE_THETA ** (-jnp.arange(half, dtype=F32) / half)
    ang = pos.astype(F32)[:, None] * inv[None, :]
    cos = jnp.cos(ang)[:, None, :]
    sin = jnp.sin(ang)[:, None, :]
    x1 = x[..., :half].astype(F32)
    x2 = x[..., half:].astype(F32)
    return jnp.concatenate([x1 * cos - x2 * sin, x1 * sin + x2 * cos], axis=-1).astype(x.dtype)


def split_cols(t, sizes):
    offs = np.cumsum(sizes)[:-1].tolist()
    return jnp.split(t, offs, axis=-1)


def diff_attention(q, k, v, lam):
    S = q.shape[3]
    scale = HEAD_DIM ** -0.5
    outs = []
    for start in range(0, S, Q_BLOCK):
        end = start + Q_BLOCK
        s = jnp.einsum('bhmqd,bhmkd->bhmqk', q[:, :, :, start:end], k[:, :, :, :end]).astype(F32) * scale
        causal = jnp.arange(start, end)[:, None] >= jnp.arange(end)[None, :]
        pr = jax.nn.softmax(jnp.where(causal, s, -jnp.inf), axis=-1)
        a = pr[:, :, 0] - lam * pr[:, :, 1]
        outs.append(jnp.einsum('bhqk,bhkd->bhqd', a.astype(v.dtype), v[:, :, :end]))
    return jnp.concatenate(outs, axis=2)


def dilated_branch(q, k, v, window, dilation):
    Bn, H, S, dh = q.shape
    steps = window // dilation
    L = S // dilation
    nb = -(-L // B_BLOCK)
    Lp = nb * B_BLOCK

    def strided(t):
        t = t.reshape(Bn, H, L, dilation, dh).transpose(0, 1, 3, 2, 4)
        t = jnp.pad(t, ((0, 0), (0, 0), (0, 0), (0, Lp - L), (0, 0)))
        return t.reshape(Bn, H, dilation, nb, B_BLOCK, dh)

    def with_prev(t):
        prev = jnp.pad(t, ((0, 0), (0, 0), (0, 0), (1, 0), (0, 0), (0, 0)))[:, :, :, :-1]
        return jnp.concatenate([prev, t], axis=-2)

    qb = strided(q)
    kk = with_prev(strided(k))
    vv = with_prev(strided(v))
    s = jnp.einsum('bhcnqd,bhcnkd->bhcnqk', qb, kk).astype(F32) * dh ** -0.5
    ki = jnp.arange(2 * B_BLOCK)[None, :]
    dist = (jnp.arange(B_BLOCK)[:, None] + B_BLOCK) - ki
    blk = jnp.arange(nb)[:, None, None]
    ok = (dist >= 0) & (dist <= steps) & ((blk > 0) | (ki >= B_BLOCK))
    s = jnp.where(ok, s, -jnp.inf)
    lse = jax.nn.logsumexp(s, axis=-1)
    pr = jnp.exp(s - lse[..., None])
    o = jnp.einsum('bhcnqk,bhcnkd->bhcnqd', pr.astype(v.dtype), vv)
    o = o.reshape(Bn, H, dilation, Lp, dh)[:, :, :, :L].transpose(0, 1, 3, 2, 4).reshape(Bn, H, S, dh)
    lse = lse.reshape(Bn, H, dilation, Lp)[..., :L].transpose(0, 1, 3, 2).reshape(Bn, H, S)
    return o, lse


def dilated_attention(q, k, v):
    res = [dilated_branch(q, k, v, w, d) for (w, d) in B_BRANCHES]
    outs = jnp.stack([r[0] for r in res]).astype(F32)
    lses = jnp.stack([r[1] for r in res])
    wts = jax.nn.softmax(lses, axis=0)
    return jnp.einsum('gbhs,gbhsd->bhsd', wts, outs)


def mixer_ab(h, pos, w_in, w_out, lq1, lk1, lq2, lk2, g_sub, lam_init):
    Bn, S, _ = h.shape
    aq, ak, av, bq, bk, bv = split_cols(h @ w_in, AB_SPLITS)
    def a_qk(t):
        t = rope(t.reshape(Bn, S, A_HEADS * 2, HEAD_DIM), pos)
        return t.reshape(Bn, S, A_HEADS, 2, HEAD_DIM).transpose(0, 2, 3, 1, 4)
    av = av.reshape(Bn, S, A_HEADS, A_VDIM).transpose(0, 2, 1, 3)
    lam = (jnp.exp(jnp.sum(lq1.astype(F32) * lk1.astype(F32)))
           - jnp.exp(jnp.sum(lq2.astype(F32) * lk2.astype(F32))) + lam_init)
    ao = diff_attention(a_qk(aq), a_qk(ak), av, lam)
    ao = rms(ao, g_sub) * (1.0 - lam_init)
    ao = ao.transpose(0, 2, 1, 3).reshape(Bn, S, A_HEADS * A_VDIM)
    def b_heads(t, rot):
        t = t.reshape(Bn, S, B_HEADS, HEAD_DIM)
        t = rope(t, pos) if rot else t
        return t.transpose(0, 2, 1, 3)
    bo = dilated_attention(b_heads(bq, True), b_heads(bk, True), b_heads(bv, False))
    bo = bo.transpose(0, 2, 1, 3).reshape(Bn, S, B_HEADS * HEAD_DIM).astype(h.dtype)
    return jnp.concatenate([ao.astype(h.dtype), bo], axis=-1) @ w_out


def partial_rope(t, pos):
    return jnp.concatenate([rope(t[..., :IDX_ROPE], pos), t[..., IDX_ROPE:]], axis=-1)


def mixer_c(h, pos, w_in, g_cq, g_ckv, w_uq, w_qi, w_uk, w_uv, w_out):
    Bn, S, _ = h.shape
    cq, ckv, krope, kidx, widx = split_cols(h @ w_in, C_SPLITS)
    cq = rms(cq, g_cq)
    ckv = rms(ckv, g_ckv)
    q = (cq @ w_uq).reshape(Bn, S, C_HEADS, C_NOPE + C_ROPE)
    q_lat = jnp.einsum('bshd,chd->bshc', q[..., :C_NOPE], w_uk)
    q_full = jnp.concatenate([q_lat, rope(q[..., C_NOPE:], pos)], axis=-1)
    k_rope = rope(krope[:, :, None, :], pos)[:, :, 0]
    kv = jnp.concatenate([ckv, k_rope], axis=-1)
    qi = partial_rope((cq @ w_qi).reshape(Bn, S, IDX_HEADS, IDX_DIM), pos)
    ki = partial_rope(kidx[:, :, None, :], pos)[:, :, 0]
    wi = widx.astype(F32) * IDX_HEADS ** -0.5
    k_sel = min(TOPK_MAX, S // 4)
    nb = S // Q_BLOCK

    def blocks(t):
        return t.reshape((Bn, nb, Q_BLOCK) + t.shape[2:]).swapaxes(0, 1)

    def one_block(args):
        qf, qib, wib, start = args
        tq = start + jnp.arange(Q_BLOCK)
        dots = jnp.einsum('bqhd,bsd->bqhs', qib, ki).astype(F32)
        score = jnp.einsum('bqh,bqhs->bqs', wib, jax.nn.relu(dots)) * IDX_DIM ** -0.5
        causal = jnp.arange(S)[None, :] <= tq[:, None]
        score = jnp.where(causal, score, -jnp.inf)
        _, idx = lax.top_k(score, k_sel)
        valid = idx <= tq[None, :, None]
        sel = jax.vmap(lambda kvb, ib: kvb[ib])(kv, idx)
        s = jnp.einsum('bqhc,bqkc->bqhk', qf, sel).astype(F32) * C_SCALE
        pr = jax.nn.softmax(jnp.where(valid[:, :, None, :], s, -jnp.inf), axis=-1)
        o_lat = jnp.einsum('bqhk,bqkc->bqhc', pr.astype(sel.dtype), sel[..., :C_KV_RANK])
        return jnp.einsum('bqhc,chd->bqhd', o_lat, w_uv)

    o = lax.map(one_block, (blocks(q_full), blocks(qi), blocks(wi), jnp.arange(nb) * Q_BLOCK))
    o = o.swapaxes(0, 1).reshape(Bn, S, C_OUT)
    return o @ w_out


def setup_inputs(seed: int = 0) -> dict:
    key = jax.random.key(seed)
    ks = iter(jax.random.split(key, 32))

    def nrm(shape, fan_in):
        return jax.random.normal(next(ks), shape, F32) * fan_in ** -0.5

    def gain(shape):
        return 1.0 + 0.02 * jax.random.normal(next(ks), shape, F32)

    def small(shape):
        return 0.1 * jax.random.normal(next(ks), shape, F32)

    return {
        "x": jax.random.normal(next(ks), (BATCH, SEQ, D_MODEL), F32),
        "p": jax.random.normal(next(ks), (DEPTH, BATCH, SEQ, PLE_DIM), F32),
        "g_mix_pre": gain((DEPTH, D_MODEL)),
        "g_mix_post": gain((DEPTH, D_MODEL)),
        "g_mlp_pre": gain((DEPTH, D_MODEL)),
        "g_mlp_post": gain((DEPTH, D_MODEL)),
        "w_mlp_in": nrm((DEPTH, D_MODEL, D_FF), D_MODEL),
        "w_mlp_out": nrm((DEPTH, D_FF, D_MODEL), D_FF),
        "w_ple_proj": nrm((DEPTH, PLE_DIM, D_MODEL), PLE_DIM),
        "w_ple_gate": nrm((DEPTH, D_MODEL, D_MODEL), D_MODEL),
        "w_in_ab": nrm((N_EVEN, D_MODEL, AB_IN), D_MODEL),
        "w_out_ab": nrm((N_EVEN, AB_OUT, D_MODEL), AB_OUT),
        "diff_lq1": small((N_EVEN, HEAD_DIM)),
        "diff_lk1": small((N_EVEN, HEAD_DIM)),
        "diff_lq2": small((N_EVEN, HEAD_DIM)),
        "diff_lk2": small((N_EVEN, HEAD_DIM)),
        "g_diff_sub": gain((N_EVEN, A_VDIM)),
        "w_in_c": nrm((N_ODD, D_MODEL, C_IN), D_MODEL),
        "g_cq": gain((N_ODD, C_Q_RANK)),
        "g_ckv": gain((N_ODD, C_KV_RANK)),
        "w_uq": nrm((N_ODD, C_Q_RANK, C_HEADS * (C_NOPE + C_ROPE)), C_Q_RANK),
        "w_qi": nrm((N_ODD, C_Q_RANK, IDX_HEADS * IDX_DIM), C_Q_RANK),
        "w_uk": nrm((N_ODD, C_KV_RANK, C_HEADS, C_NOPE), C_KV_RANK),
        "w_uv": nrm((N_ODD, C_KV_RANK, C_HEADS, C_VDIM), C_KV_RANK),
        "w_out_c": nrm((N_ODD, C_OUT, D_MODEL), C_OUT),
    }


def reference(x, p, g_mix_pre, g_mix_post, g_mlp_pre, g_mlp_post, w_mlp_in, w_mlp_out,
              w_ple_proj, w_ple_gate, w_in_ab, w_out_ab, diff_lq1, diff_lk1, diff_lq2,
              diff_lk2, g_diff_sub, w_in_c, g_cq, g_ckv, w_uq, w_qi, w_uk, w_uv, w_out_c):
    S = x.shape[1]
    pos = jnp.arange(S)
    h = x
    for i in range(DEPTH):
        hn = rms(h, g_mix_pre[i])
        j = i // 2
        if i % 2 == 0:
            lam_init = 0.8 - 0.6 * math.exp(-0.3 * i)
            y = mixer_ab(hn, pos, w_in_ab[j], w_out_ab[j], diff_lq1[j], diff_lk1[j],
                         diff_lq2[j], diff_lk2[j], g_diff_sub[j], lam_init)
        else:
            y = mixer_c(hn, pos, w_in_c[j], g_cq[j], g_ckv[j], w_uq[j], w_qi[j],
                        w_uk[j], w_uv[j], w_out_c[j])
        h = h + rms(y, g_mix_post[i])
        hn = rms(h, g_mlp_pre[i])
        y = jnp.square(jax.nn.relu(hn @ w_mlp_in[i])) @ w_mlp_out[i]
        h = h + rms(y, g_mlp_post[i])
        gate = jax.nn.sigmoid(h @ w_ple_gate[i])
        h = h + gate * (p[i] @ w_ple_proj[i])
    return h
```

```cpp
#include <hip/hip_runtime.h>
#include <hip/hip_cooperative_groups.h>
#include <cstdio>
#include <cstdint>
namespace cg = cooperative_groups;
namespace pg8 {
#define PG8_LAS __attribute__((address_space(3)))
typedef unsigned short bf16_t;
typedef short bf16x8 __attribute__((ext_vector_type(8)));
typedef float f32x4 __attribute__((ext_vector_type(4)));
typedef unsigned u32x4 __attribute__((ext_vector_type(4)));
constexpr int BM = 256, BK = 64, HALF = 128, HTB = HALF * BK * 2  , STAGE_BYTES = 8 * HTB, NXCD = 8, WGM = 8;

__host__ __device__ __forceinline__ int lds_byte(int r, int c) { const int st = (r >> 4) * 2 + (c >> 5), rr = r & 15, cc = c & 31, ob = rr * 64 + cc * 2; return st * 1024 + (ob ^ (((ob >> 9) & 1) << 5)); }
__host__ __device__ __forceinline__ void stage_rc(int b, int& R, int& C) { const int st = b / 1024, sb = b % 1024, swz = sb ^ (((sb >> 9) & 1) << 5); R = (st >> 1) * 16 + swz / 64; C = (st & 1) * 32 + (swz % 64) / 2; }
__host__ __device__ __forceinline__ int perm32(int rho) { const int n = rho >> 4, i = rho & 15; return 8 * (i >> 2) + 4 * n + (i & 3); }

struct Unit { int pm, pn; };
struct Gemm { const bf16_t* A; const bf16_t* Bt; int M, N, K; };

struct StaticOrder {
    int nM, nN, nwg, G, c;
    __host__ __device__ void init(int M, int N, int G_, int c_) { nM = M / BM; nN = N / BM; nwg = nM * nN; G = G_; c = c_; }
    __host__ __device__ bool next(int i, Unit& u) const {
        const long L = (long)i * G + c; if (L >= nwg) return false;
        int wgid = (int)L; { const int q = nwg / NXCD, r = nwg % NXCD, xcd = wgid % NXCD, off = wgid / NXCD; wgid = (xcd < r ? xcd * (q + 1) : r * (q + 1) + (xcd - r) * q) + off; }
        const int nig = WGM * nN, gid = wgid / nig, fm = gid * WGM, gsz = (nM - fm) < WGM ? (nM - fm) : WGM;
        u.pm = fm + ((wgid % nig) % gsz); u.pn = (wgid % nig) / gsz; return true;
    }
    __device__ __forceinline__ void a_ready(const Unit&) const {}
    __device__ __forceinline__ void done(const Unit&) const {}
};

__device__ __forceinline__ unsigned cvt_pk_bf16(float lo, float hi) { unsigned r; asm volatile("v_cvt_pk_bf16_f32 %0, %1, %2" : "=v"(r) : "v"(lo), "v"(hi)); return r; }
typedef float f32x2 __attribute__((ext_vector_type(2)));
__device__ __forceinline__ f32x2 gelu_pk(f32x2 v) {
    const f32x2 av = __builtin_elementwise_abs(v), d = av * 0.2316418882f + 1.0f;
    f32x2 t; t.x = __builtin_amdgcn_rcpf(d.x); t.y = __builtin_amdgcn_rcpf(d.y);
    f32x2 q = t * 0.5307027145f + (-0.7265760135f); q = q * t + 0.7107068705f; q = q * t + (-0.142248368f); q = q * t + 0.127414796f; q = q * t;
    const f32x2 s = (v * v) * (-0.72134752044f);
    f32x2 e; e.x = __builtin_amdgcn_exp2f(s.x); e.y = __builtin_amdgcn_exp2f(s.y);
    const f32x2 m = v * (q * e), r = v - m;
    f32x2 o; o.x = v.x < 0.f ? m.x : r.x; o.y = v.y < 0.f ? m.y : r.y; return o;
}

template <int ACT  > struct EpiBf16 {
    static constexpr bool PERM = true, AFTER_DRAIN = false; static_assert(ACT == 0 || ACT == 1, "EpiBf16: ACT is 0 (none) or 1 (gelu_pk)");
    bf16_t* O; int ldc; const float* bias; int split_cols; size_t split_stride; float scale0;
    __device__ __forceinline__ void operator()(const f32x4 (&acc)[2][2][4][2], const Unit& u, int wr, int wc, int fr, int fq) const {
        const int row0 = u.pm * BM + wr * 64 + fr; int colt = u.pn * BM; bf16_t* base = O;
        float sc = 1.f; if (split_cols) { const int t = colt / split_cols; base += (size_t)t * split_stride; colt -= t * split_cols; if (t == 0) sc = scale0; }
        const int col0 = colt + wc * 32 + 8 * fq, bcol0 = u.pn * BM + wc * 32 + 8 * fq;
        f32x4 bv[2][2];
#pragma unroll
        for (int bj = 0; bj < 2; ++bj)
#pragma unroll
            for (int n = 0; n < 2; ++n) bv[bj][n] = bias ? *(const f32x4*)(bias + bcol0 + bj * HALF + 4 * n) : (f32x4){0.f, 0.f, 0.f, 0.f};
#pragma unroll
        for (int ai = 0; ai < 2; ++ai)
#pragma unroll
            for (int m = 0; m < 4; ++m) { bf16_t* rowp = base + (size_t)(row0 + ai * HALF + m * 16) * ldc + col0;
#pragma unroll
                for (int bj = 0; bj < 2; ++bj) { f32x4 v0 = acc[ai][bj][m][0] + bv[bj][0], v1 = acc[ai][bj][m][1] + bv[bj][1];
                    if (ACT == 1) { v0 = __builtin_elementwise_max(v0, (f32x4){0.f, 0.f, 0.f, 0.f}); v1 = __builtin_elementwise_max(v1, (f32x4){0.f, 0.f, 0.f, 0.f}); v0 = v0 * v0; v1 = v1 * v1; }
                    v0 = v0 * sc; v1 = v1 * sc; u32x4 w; w.x = cvt_pk_bf16(v0[0], v0[1]); w.y = cvt_pk_bf16(v0[2], v0[3]); w.z = cvt_pk_bf16(v1[0], v1[1]); w.w = cvt_pk_bf16(v1[2], v1[3]);
                    *(u32x4*)(rowp + bj * HALF) = w; } }
    }
};

struct PanelStats {
    unsigned* xbuf;
    unsigned* cnt;
    unsigned* tmo;
    int ntn; float eps;
    unsigned code;
    __device__ __forceinline__ bool run(const f32x4 (&v)[2][2][4][2], const Unit& u, int wr, int wc, int fr, int fq, PG8_LAS unsigned char* lds, int wid, int lane) const {
        typedef float f32x2v __attribute__((ext_vector_type(2)));
        PG8_LAS f32x2v* P = (PG8_LAS f32x2v*)lds;
        PG8_LAS f32x2v* S = (PG8_LAS f32x2v*)(lds + 8192);
        PG8_LAS unsigned* flag = (PG8_LAS unsigned*)(lds + 8192 + 2048);
#pragma unroll
        for (int ai = 0; ai < 2; ++ai)
#pragma unroll
            for (int m = 0; m < 4; ++m) {
                float s = 0.f;
#pragma unroll
                for (int bj = 0; bj < 2; ++bj)
#pragma unroll
                    for (int n = 0; n < 2; ++n) { const f32x4 x = v[ai][bj][m][n]; s += (x[0] + x[1]) + (x[2] + x[3]); }
                s += __shfl_xor(s, 16); s += __shfl_xor(s, 32);
                const float mw = s * (1.0f / 64.0f); float q = 0.f;
#pragma unroll
                for (int bj = 0; bj < 2; ++bj)
#pragma unroll
                    for (int n = 0; n < 2; ++n) { const f32x4 d = v[ai][bj][m][n] - mw; q += (d[0] * d[0] + d[1] * d[1]) + (d[2] * d[2] + d[3] * d[3]); }
                q += __shfl_xor(q, 16); q += __shfl_xor(q, 32);
                if (fq == 0) P[(ai * HALF + wr * 64 + m * 16 + fr) * 4 + wc] = (f32x2v){mw, q};
            }
        asm volatile("s_waitcnt lgkmcnt(0)" ::: "memory"); __builtin_amdgcn_s_barrier(); asm volatile("" ::: "memory");
#if defined(BROKEN_EXCHANGE_NO_WAIT)
#warning BROKEN CONTROL BUILD: the row-statistics exchange does not wait; results are wrong by design
        if (blockIdx.x >= 64) { const long long t0_ = clock64(); while (clock64() - t0_ < 60000) __builtin_amdgcn_s_sleep(8); }
#endif
        const int row = wid * 32 + (lane & 31);
        if (lane < 32) {
            const f32x2v a = P[row * 4 + 0], b = P[row * 4 + 1], c = P[row * 4 + 2], d = P[row * 4 + 3];
            const float mt = (a.x + b.x + c.x + d.x) * 0.25f;
            const float da = a.x - mt, db = b.x - mt, dc = c.x - mt, dd = d.x - mt;
            const float m2 = (a.y + b.y) + (c.y + d.y) + 64.0f * ((da * da + db * db) + (dc * dc + dd * dd));
            unsigned long long* slot = (unsigned long long*)xbuf + ((size_t)(u.pm * BM + row) * 4 + u.pn);
            __hip_atomic_store(slot, ((unsigned long long)__float_as_uint(m2) << 32) | __float_as_uint(mt), __ATOMIC_RELAXED, __HIP_MEMORY_SCOPE_AGENT);
        }
        asm volatile("s_waitcnt vmcnt(0)" ::: "memory");
        if (lane == 0) __hip_atomic_fetch_add(cnt + 64 * u.pm, 1u, __ATOMIC_RELAXED, __HIP_MEMORY_SCOPE_AGENT);
        if (wid == 0) {
            bool dead = false; const unsigned long long t0 = __builtin_amdgcn_s_memrealtime(); const unsigned want = 8u * (unsigned)ntn;
            for (;;) {
#if defined(BROKEN_EXCHANGE_NO_WAIT)
                break;
#endif
                if ((unsigned)__builtin_amdgcn_readfirstlane(__hip_atomic_load(cnt + 64 * u.pm, __ATOMIC_RELAXED, __HIP_MEMORY_SCOPE_AGENT)) >= want) break;
                if (__builtin_amdgcn_s_memrealtime() - t0 > 2000000ull) {
                    if (lane == 0) { unsigned expect = 0u; __hip_atomic_compare_exchange_strong(tmo + 1, &expect, code | (unsigned)(u.pm & 0xff), __ATOMIC_RELAXED, __ATOMIC_RELAXED, __HIP_MEMORY_SCOPE_AGENT);
                                     __hip_atomic_store(tmo, 1u, __ATOMIC_RELAXED, __HIP_MEMORY_SCOPE_AGENT); }
                    dead = true; break; }
                __builtin_amdgcn_s_sleep(2);
            }
            __builtin_amdgcn_fence(__ATOMIC_ACQUIRE, "agent");
            if (lane == 0) flag[0] = dead ? 1u : 0u;
        }
        asm volatile("s_waitcnt vmcnt(0) lgkmcnt(0)" ::: "memory"); __builtin_amdgcn_s_barrier(); asm volatile("" ::: "memory");
        const bool bad = flag[0] != 0u;
        if (lane < 32) {
            const unsigned long long* slot = (const unsigned long long*)xbuf + (size_t)(u.pm * BM + row) * 4; float mt[4], m2[4]; float ms = 0.f;
#pragma unroll
            for (int t = 0; t < 4; ++t) { if (t < ntn) { const unsigned long long w = __hip_atomic_load(slot + t, __ATOMIC_RELAXED, __HIP_MEMORY_SCOPE_AGENT); mt[t] = __uint_as_float((unsigned)w); m2[t] = __uint_as_float((unsigned)(w >> 32)); } else { mt[t] = 0.f; m2[t] = 0.f; } ms += mt[t]; }
            const float mean = ms / (float)ntn; float q = 0.f;
#pragma unroll
            for (int t = 0; t < 4; ++t) if (t < ntn) { const float dm = mt[t] - mean; q += m2[t] + 256.0f * dm * dm; }
            S[row] = (f32x2v){mean, 1.0f / sqrtf(q / (256.0f * (float)ntn) + eps)};
        }
        asm volatile("s_waitcnt lgkmcnt(0)" ::: "memory"); __builtin_amdgcn_s_barrier(); asm volatile("" ::: "memory");
        return bad;
    }
};
struct EpiLnRes {
    static constexpr bool PERM = false, AFTER_DRAIN = true;
    const float* base; float* out; int ldc; const float* bias; PanelStats st; unsigned poison;
    __device__ __forceinline__ void fused(f32x4 (&acc)[2][2][4][2], const Unit& u, int wr, int wc, int fr, int fq, PG8_LAS unsigned char* lds, int wid, int lane) const {
        typedef float f32x2v __attribute__((ext_vector_type(2)));
        const PG8_LAS f32x2v* S = (const PG8_LAS f32x2v*)(lds + 8192);
        const int col0 = u.pn * BM + wc * 32 + 4 * fq;
#pragma unroll
        for (int bj = 0; bj < 2; ++bj)
#pragma unroll
            for (int n = 0; n < 2; ++n) { const f32x4 bv = bias ? *(const f32x4*)(bias + col0 + bj * HALF + n * 16) : (f32x4){0.f, 0.f, 0.f, 0.f};
#pragma unroll
                for (int ai = 0; ai < 2; ++ai)
#pragma unroll
                    for (int m = 0; m < 4; ++m) acc[ai][bj][m][n] += bv; }
        f32x4 pre[4][2][2];
#pragma unroll
        for (int m = 0; m < 4; ++m) { const size_t off = (size_t)(u.pm * BM + wr * 64 + m * 16 + fr) * ldc + col0;
#pragma unroll
            for (int bj = 0; bj < 2; ++bj)
#pragma unroll
                for (int n = 0; n < 2; ++n) pre[m][bj][n] = *(const f32x4*)(base + off + bj * HALF + n * 16); }
        const bool bad = st.run(acc, u, wr, wc, fr, fq, lds, wid, lane) || poison != 0u;
        const float qnan = __builtin_nanf("");
#pragma unroll
        for (int ai = 0; ai < 2; ++ai)
#pragma unroll
            for (int m = 0; m < 4; ++m) { const int r = ai * HALF + wr * 64 + m * 16 + fr; const f32x2v sr = S[r]; const size_t off = (size_t)(u.pm * BM + r) * ldc + col0;
#pragma unroll
                for (int bj = 0; bj < 2; ++bj)
#pragma unroll
                    for (int n = 0; n < 2; ++n) { const f32x4 bs = ai == 0 ? pre[m][bj][n] : *(const f32x4*)(base + off + bj * HALF + n * 16); f32x4 o = bs + (acc[ai][bj][m][n] - sr.x) * sr.y;
                        if (bad) o = (f32x4){qnan, qnan, qnan, qnan}; *(f32x4*)(out + off + bj * HALF + n * 16) = o; }
                if (m & 1) asm volatile("" ::: "memory"); }
    }
};
struct EpiLnResLn {
    static constexpr bool PERM = false, AFTER_DRAIN = true;
    const float* base; float* out; bf16_t* xn; int ldc; const float* bias; PanelStats st1, st2; unsigned poison;
    __device__ __forceinline__ void fused(f32x4 (&acc)[2][2][4][2], const Unit& u, int wr, int wc, int fr, int fq, PG8_LAS unsigned char* lds, int wid, int lane) const {
        typedef float f32x2v __attribute__((ext_vector_type(2))); typedef unsigned u32x2v __attribute__((ext_vector_type(2)));
        const PG8_LAS f32x2v* S = (const PG8_LAS f32x2v*)(lds + 8192);
        const int col0 = u.pn * BM + wc * 32 + 4 * fq;
#pragma unroll
        for (int bj = 0; bj < 2; ++bj)
#pragma unroll
            for (int n = 0; n < 2; ++n) { const f32x4 bv = bias ? *(const f32x4*)(bias + col0 + bj * HALF + n * 16) : (f32x4){0.f, 0.f, 0.f, 0.f};
#pragma unroll
                for (int ai = 0; ai < 2; ++ai)
#pragma unroll
                    for (int m = 0; m < 4; ++m) acc[ai][bj][m][n] += bv; }
        bool bad = st1.run(acc, u, wr, wc, fr, fq, lds, wid, lane) || poison != 0u;
        const float qnan = __builtin_nanf("");
#pragma unroll
        for (int ai = 0; ai < 2; ++ai)
#pragma unroll
            for (int m = 0; m < 4; ++m) { const int r = ai * HALF + wr * 64 + m * 16 + fr; const f32x2v sr = S[r]; const size_t off = (size_t)(u.pm * BM + r) * ldc + col0;
#pragma unroll
                for (int bj = 0; bj < 2; ++bj)
#pragma unroll
                    for (int n = 0; n < 2; ++n) { const f32x4 bs = *(const f32x4*)(base + off + bj * HALF + n * 16); acc[ai][bj][m][n] = bs + (acc[ai][bj][m][n] - sr.x) * sr.y; }
                asm volatile("" : "+v"(acc[ai][0][m][0]), "+v"(acc[ai][0][m][1]), "+v"(acc[ai][1][m][0]), "+v"(acc[ai][1][m][1]));
                if (m & 1) asm volatile("" ::: "memory"); }
        const bool bad1 = bad;
        bad = st2.run(acc, u, wr, wc, fr, fq, lds, wid, lane) || bad;
#pragma unroll
        for (int ai = 0; ai < 2; ++ai)
#pragma unroll
            for (int m = 0; m < 4; ++m) { const int r = ai * HALF + wr * 64 + m * 16 + fr; const f32x2v sr = S[r]; const size_t off = (size_t)(u.pm * BM + r) * ldc + col0;
#pragma unroll
                for (int bj = 0; bj < 2; ++bj)
#pragma unroll
                    for (int n = 0; n < 2; ++n) { const f32x4 x1 = acc[ai][bj][m][n]; *(f32x4*)(out + off + bj * HALF + n * 16) = bad1 ? (f32x4){qnan, qnan, qnan, qnan} : x1;
                        const f32x4 o = (x1 - sr.x) * sr.y; u32x2v w; w.x = cvt_pk_bf16(o[0], o[1]); w.y = cvt_pk_bf16(o[2], o[3]);
                        if (bad) { w.x = 0x7fc07fc0u; w.y = 0x7fc07fc0u; } *(u32x2v*)(xn + off + bj * HALF + n * 16) = w; }
                asm volatile("" ::: "memory"); }
    }
};

struct EpiF32 {
    static constexpr bool PERM = false, AFTER_DRAIN = false;
    float* O; int ldc;
    __device__ __forceinline__ void operator()(const f32x4 (&acc)[2][2][4][2], const Unit& u, int wr, int wc, int fr, int fq) const {
        const int row0 = u.pm * BM + wr * 64 + fr, col0 = u.pn * BM + wc * 32 + 4 * fq;
#pragma unroll
        for (int ai = 0; ai < 2; ++ai)
#pragma unroll
            for (int m = 0; m < 4; ++m) { float* rowp = O + (size_t)(row0 + ai * HALF + m * 16) * ldc + col0;
#pragma unroll
                for (int bj = 0; bj < 2; ++bj)
#pragma unroll
                    for (int n = 0; n < 2; ++n) *(f32x4*)(rowp + bj * HALF + n * 16) = acc[ai][bj][m][n]; }
    }
};
struct EpiGate {
    static constexpr bool PERM = false, AFTER_DRAIN = false;
    float* H; const float* P; int ldc;
    __device__ __forceinline__ void operator()(const f32x4 (&acc)[2][2][4][2], const Unit& u, int wr, int wc, int fr, int fq) const {
        const int row0 = u.pm * BM + wr * 64 + fr, col0 = u.pn * BM + wc * 32 + 4 * fq;
#pragma unroll
        for (int ai = 0; ai < 2; ++ai)
#pragma unroll
            for (int m = 0; m < 4; ++m) { const size_t off = (size_t)(row0 + ai * HALF + m * 16) * ldc + col0;
#pragma unroll
                for (int bj = 0; bj < 2; ++bj)
#pragma unroll
                    for (int n = 0; n < 2; ++n) { const size_t o = off + bj * HALF + n * 16; const f32x4 a = acc[ai][bj][m][n], pv = *(const f32x4*)(P + o), hv = *(const f32x4*)(H + o); f32x4 r;
#pragma unroll
                        for (int e = 0; e < 4; ++e) r[e] = hv[e] + pv[e] * __builtin_amdgcn_rcpf(1.0f + __builtin_amdgcn_exp2f(-1.4426950408889634f * a[e]));
                        *(f32x4*)(H + o) = r; } }
    }
};

template <class Epi, class Sched, bool ALIGN_EPI = false, bool SP2 = false>
__device__ __forceinline__ void gemm_phase(PG8_LAS unsigned char* lds, const Gemm g, const Sched& S, const Epi& E) {
    int tid_ = threadIdx.x; asm volatile("" : "+v"(tid_));
    const int tid = tid_, wid = __builtin_amdgcn_readfirstlane(tid >> 6), lane = tid & 63, wr = wid >> 2, wc = wid & 3, fr = lane & 15, fq = lane >> 4;
    const int K = g.K, nt = K / BK;
    unsigned voffA[2], voffB[2];
#pragma unroll
    for (int i = 0; i < 2; ++i) { int R, C; stage_rc(tid * 16 + i * 8192, R, C); const int Rb = Epi::PERM ? ((R & ~31) + perm32(R & 31)) : R;
        voffA[i] = (unsigned)(R * K + C) * 2u; voffB[i] = (unsigned)(Rb * K + C) * 2u; }
    const size_t kstep = (size_t)(BK * 2);
    const size_t hstep = (size_t)HALF * K * 2;
    const size_t tstep = 2 * hstep;
    const unsigned ldsw = (unsigned)wid * 1024u;
    const int aoff = lds_byte(wr * 64 + fr, fq * 8), boff = lds_byte(wc * 32 + fr, fq * 8);
#define PG8_SA(b, h) (((b) * 2 + (h)) * HTB)
#define PG8_SB(b, h) ((4 + (b) * 2 + (h)) * HTB)
#define PG8_STAGE(bufoff, gbase, voff) do { _Pragma("unroll") for (int _i = 0; _i < 2; ++_i) \
        __builtin_amdgcn_global_load_lds((const unsigned*)((const char*)(gbase) + (voff)[_i]), (PG8_LAS unsigned*)(lds + (bufoff) + ldsw + _i * 8192), 16, 0, 0); } while (0)
#define PG8_LDA(dst, b, h) do { _Pragma("unroll") for (int m = 0; m < 4; ++m) _Pragma("unroll") for (int k = 0; k < 2; ++k) dst[m][k] = *(const PG8_LAS bf16x8*)(lds + PG8_SA(b, h) + aoff + m * 2048 + k * 1024); } while (0)
#define PG8_LDB(dst, b, h) do { _Pragma("unroll") for (int n = 0; n < 2; ++n) _Pragma("unroll") for (int k = 0; k < 2; ++k) dst[n][k] = *(const PG8_LAS bf16x8*)(lds + PG8_SB(b, h) + boff + n * 2048 + k * 1024); } while (0)
#define PG8_MMA(ai, bj, At, Bt) do { __builtin_amdgcn_s_setprio(1); _Pragma("unroll") for (int m = 0; m < 4; ++m) _Pragma("unroll") for (int n = 0; n < 2; ++n) _Pragma("unroll") for (int k = 0; k < 2; ++k) \
        acc[ai][bj][m][n] = __builtin_amdgcn_mfma_f32_16x16x32_bf16(Bt[n][k], At[m][k], acc[ai][bj][m][n], 0, 0, 0); __builtin_amdgcn_s_setprio(0); } while (0)
#define PG8_WAIT_V(n) asm volatile("s_waitcnt vmcnt(" #n ")" ::: "memory")
#define PG8_WAIT_L(n) asm volatile("s_waitcnt lgkmcnt(" #n ")" ::: "memory")
#define PG8_BAR __builtin_amdgcn_s_barrier()
#define PG8_SCHED __builtin_amdgcn_sched_barrier(0)
    Unit cur, nxt; int ui = 0;
    if (!S.next(0, cur)) return;
    f32x4 acc[2][2][4][2];
#pragma unroll
    for (int a = 0; a < 2; ++a)
#pragma unroll
        for (int b = 0; b < 2; ++b)
#pragma unroll
            for (int m = 0; m < 4; ++m)
#pragma unroll
                for (int n = 0; n < 2; ++n) acc[a][b][m][n] = (f32x4){0.f, 0.f, 0.f, 0.f};
    bf16x8 At[4][2], B0[2][2], B1[2][2];
    const char* cA = (const char*)g.A + (size_t)cur.pm * tstep; const char* cB = (const char*)g.Bt + (size_t)cur.pn * tstep;
    S.a_ready(cur);
    if constexpr (SP2) {
        PG8_STAGE(PG8_SB(0, 0), cB, voffB); PG8_STAGE(PG8_SB(0, 1), cB + hstep, voffB); PG8_STAGE(PG8_SA(0, 0), cA, voffA); PG8_STAGE(PG8_SA(0, 1), cA + hstep, voffA);
        if (wr == 1) PG8_BAR;
        PG8_WAIT_V(2); PG8_BAR;
        PG8_STAGE(PG8_SB(1, 0), cB + kstep, voffB); PG8_STAGE(PG8_SA(1, 0), cA + kstep, voffA); PG8_STAGE(PG8_SB(1, 1), cB + hstep + kstep, voffB);
        PG8_WAIT_V(6); PG8_BAR;
    } else {
        PG8_STAGE(PG8_SB(0, 0), cB, voffB); PG8_STAGE(PG8_SA(0, 0), cA, voffA); PG8_STAGE(PG8_SB(0, 1), cB + hstep, voffB); PG8_STAGE(PG8_SA(0, 1), cA + hstep, voffA);
        if (wr == 1) PG8_BAR;
        PG8_WAIT_V(4); PG8_BAR;
        PG8_STAGE(PG8_SB(1, 0), cB + kstep, voffB); PG8_STAGE(PG8_SA(1, 0), cA + kstep, voffA); PG8_STAGE(PG8_SB(1, 1), cB + hstep + kstep, voffB);
        PG8_WAIT_V(6); PG8_BAR;
    }
    for (;;) {
        const bool has_next = S.next(ui + 1, nxt);
        const char* nA = has_next ? (const char*)g.A + (size_t)nxt.pm * tstep : cA; const char* nB = has_next ? (const char*)g.Bt + (size_t)nxt.pn * tstep : cB;
#pragma unroll 1
        for (int t = 0; t < nt; t += 2) {
            const bool last = (t == nt - 2);
            const char* a1 = cA + (size_t)(t + 1) * kstep;
            const char* a2 = last ? nA : cA + (size_t)(t + 2) * kstep; const char* b2 = last ? nB : cB + (size_t)(t + 2) * kstep;
            const char* a3 = a2 + kstep; const char* b3 = b2 + kstep;
            if (last && has_next) S.a_ready(nxt);
            if constexpr (SP2) {
            PG8_LDB(B0, 0, 0); PG8_LDB(B1, 0, 1); PG8_SCHED; PG8_LDA(At, 0, 0); PG8_STAGE(PG8_SA(1, 1), a1 + hstep, voffA);
            PG8_WAIT_V(8); PG8_WAIT_L(0); PG8_BAR; PG8_MMA(0, 0, At, B0); PG8_MMA(0, 1, At, B1); PG8_BAR; PG8_SCHED;
            PG8_LDA(At, 0, 1); PG8_STAGE(PG8_SB(0, 0), b2, voffB); PG8_STAGE(PG8_SB(0, 1), b2 + hstep, voffB); PG8_STAGE(PG8_SA(0, 0), a2, voffA);
            PG8_WAIT_V(8); PG8_WAIT_L(0); PG8_BAR; PG8_MMA(1, 0, At, B0); PG8_MMA(1, 1, At, B1); PG8_BAR; PG8_SCHED;
            PG8_LDB(B0, 1, 0); PG8_LDB(B1, 1, 1); PG8_SCHED; PG8_LDA(At, 1, 0); PG8_STAGE(PG8_SA(0, 1), a2 + hstep, voffA);
            PG8_WAIT_V(8); PG8_WAIT_L(0); PG8_BAR; PG8_MMA(0, 0, At, B0); PG8_MMA(0, 1, At, B1); PG8_BAR; PG8_SCHED;
            PG8_LDA(At, 1, 1); PG8_STAGE(PG8_SB(1, 0), b3, voffB); PG8_STAGE(PG8_SB(1, 1), b3 + hstep, voffB); PG8_STAGE(PG8_SA(1, 0), a3, voffA);
            PG8_WAIT_V(8); PG8_WAIT_L(0); PG8_BAR; PG8_MMA(1, 0, At, B0); PG8_MMA(1, 1, At, B1); PG8_BAR; PG8_SCHED;
            } else {
            PG8_LDB(B0, 0, 0); PG8_SCHED; PG8_LDA(At, 0, 0); PG8_STAGE(PG8_SA(1, 1), a1 + hstep, voffA);
            PG8_WAIT_L(8); PG8_BAR; PG8_WAIT_L(0); PG8_MMA(0, 0, At, B0); PG8_BAR; PG8_SCHED;
            PG8_LDB(B1, 0, 1); PG8_STAGE(PG8_SB(0, 0), b2, voffB);
            PG8_BAR; PG8_WAIT_L(0); PG8_MMA(0, 1, At, B1); PG8_BAR;
            PG8_LDA(At, 0, 1); PG8_STAGE(PG8_SA(0, 0), a2, voffA);
            PG8_BAR; PG8_WAIT_L(0); PG8_MMA(1, 0, At, B0); PG8_BAR; PG8_SCHED;
            PG8_STAGE(PG8_SB(0, 1), b2 + hstep, voffB);
            PG8_WAIT_V(6); PG8_BAR; PG8_MMA(1, 1, At, B1); PG8_BAR;
            PG8_LDB(B0, 1, 0); PG8_SCHED; PG8_LDA(At, 1, 0); PG8_STAGE(PG8_SA(0, 1), a2 + hstep, voffA);
            PG8_WAIT_L(8); PG8_BAR; PG8_WAIT_L(0); PG8_MMA(0, 0, At, B0); PG8_BAR; PG8_SCHED;
            PG8_LDB(B1, 1, 1); PG8_STAGE(PG8_SB(1, 0), b3, voffB);
            PG8_BAR; PG8_WAIT_L(0); PG8_MMA(0, 1, At, B1); PG8_BAR;
            PG8_LDA(At, 1, 1); PG8_STAGE(PG8_SA(1, 0), a3, voffA);
            PG8_BAR; PG8_WAIT_L(0); PG8_MMA(1, 0, At, B0); PG8_BAR; PG8_SCHED;
            PG8_STAGE(PG8_SB(1, 1), b3 + hstep, voffB);
            PG8_WAIT_V(6); PG8_BAR; PG8_MMA(1, 1, At, B1); PG8_BAR;
            }
        }
        if constexpr (ALIGN_EPI) { if (wr == 0) PG8_BAR; }
        if constexpr (!Epi::AFTER_DRAIN) { E(acc, cur, wr, wc, fr, fq); S.done(cur); }
        if (!has_next) break;
#pragma unroll
        for (int a = 0; a < 2; ++a)
#pragma unroll
            for (int b = 0; b < 2; ++b)
#pragma unroll
                for (int m = 0; m < 4; ++m)
#pragma unroll
                    for (int n = 0; n < 2; ++n) acc[a][b][m][n] = (f32x4){0.f, 0.f, 0.f, 0.f};
        cur = nxt; cA = nA; cB = nB; ++ui;
        if constexpr (ALIGN_EPI) { if (wr == 1) PG8_BAR; }
    }
    PG8_WAIT_V(0);
    if constexpr (!ALIGN_EPI) { if (wr == 0) PG8_BAR; }
    PG8_BAR;
    if constexpr (Epi::AFTER_DRAIN) { E.fused(acc, cur, wr, wc, fr, fq, lds, wid, lane); S.done(cur); }
#undef PG8_SA
#undef PG8_SB
#undef PG8_STAGE
#undef PG8_LDA
#undef PG8_LDB
#undef PG8_MMA
#undef PG8_WAIT_V
#undef PG8_WAIT_L
#undef PG8_BAR
#undef PG8_SCHED
}
}
#include <hip/hip_bf16.h>
#include <cmath>
namespace attn_body {
using bf16=__hip_bfloat16;
using bf16x8=__attribute__((ext_vector_type(8)))short;
using s16x4=__attribute__((ext_vector_type(4)))short;
using f32x16=__attribute__((ext_vector_type(16)))float;
using u32x4=__attribute__((ext_vector_type(4)))unsigned;
constexpr int BATCH=8,NHEAD=16,SEQ=4096,D=64,DM=3072,DMO=1024;
constexpr int NW=8,QBLK=32,QB=QBLK*NW,KVBLK=64,NQB=SEQ/QB;
constexpr int ATTN_UNIT_ROWS=QB;
__device__ __forceinline__ int crow(int r,int hi){return (r&3)+8*(r>>2)+4*hi;}
#define SBAR() __builtin_amdgcn_sched_barrier(0)
__device__ __forceinline__ void cmask(f32x16&p0,f32x16&p1,int jb,int qrel,int hi){
  const float NEG=-INFINITY; int kb=64*jb+4*hi;
  #pragma unroll
  for(int r=0;r<16;++r){int kv=kb+(r&3)+8*(r>>2); if(kv>qrel)p0[r]=NEG; if(kv+32>qrel)p1[r]=NEG;}
}

constexpr int NSLOT=3, SLOTB=8192;
constexpr int LDS_K=0, LDS_V=NSLOT*SLOTB, LDS_WS=2*NSLOT*SLOTB, LDS_OST=LDS_WS+NW*64*4, LDS_BYTES=LDS_OST+NW*4096;
constexpr float C2=0.125f*1.4426950408889634f;
__device__ __forceinline__ void glds16(const void*gsrc,unsigned lds_dst){unsigned keep;
  asm volatile("s_mov_b32 %0, m0\n\ts_mov_b32 m0, %2\n\ts_nop 0\n\tglobal_load_lds_dwordx4 %1, off\n\ts_mov_b32 m0, %0":"=&s"(keep):"v"(gsrc),"s"(lds_dst):"memory");}
__device__ __forceinline__ float max3f(float a,float b,float c){float r;asm("v_max3_f32 %0, %1, %2, %3":"=v"(r):"v"(a),"v"(b),"v"(c));return r;}
__device__ __forceinline__ float max2f(float a,float b){float r;asm("v_max_f32_e32 %0, %1, %2":"=v"(r):"v"(a),"v"(b));return r;}
__device__ __forceinline__ float fadd_s(float a,float b){float r;asm("v_add_f32_e32 %0, %1, %2":"=v"(r):"v"(a),"v"(b));return r;}
__device__ __forceinline__ float fsub_s(float a,float b){float r;asm("v_sub_f32_e32 %0, %1, %2":"=v"(r):"v"(a),"v"(b));return r;}
typedef float f32x2_t __attribute__((ext_vector_type(2))); typedef __bf16 bf16x2_t __attribute__((ext_vector_type(2)));
__device__ __forceinline__ unsigned cvtpk_s(float lo,float hi){f32x2_t v={lo,hi};bf16x2_t b=__builtin_convertvector(v,bf16x2_t);return __builtin_bit_cast(unsigned,b);}
#define WAIT_BAR(N) asm volatile("s_waitcnt vmcnt(" #N ") lgkmcnt(0)\n\ts_barrier":::"memory")

__device__ __forceinline__ void qkt(f32x16&p0,f32x16&p1,const char*Kslot,const bf16x8*qr,const f32x16&negm,int r32,int hi){
  const char*kb=Kslot+hi*1024+r32*16;
  #pragma unroll
  for(int d0=0;d0<4;++d0){
    const bf16x8 b0=*reinterpret_cast<const bf16x8*>(kb+d0*2048);
    const bf16x8 b1=*reinterpret_cast<const bf16x8*>(kb+d0*2048+512);
    if(d0==0){p0=__builtin_amdgcn_mfma_f32_32x32x16_bf16(b0,qr[0],negm,0,0,0);p1=__builtin_amdgcn_mfma_f32_32x32x16_bf16(b1,qr[0],negm,0,0,0);}
    else{p0=__builtin_amdgcn_mfma_f32_32x32x16_bf16(b0,qr[d0],p0,0,0,0);p1=__builtin_amdgcn_mfma_f32_32x32x16_bf16(b1,qr[d0],p1,0,0,0);}}
}
typedef __attribute__((address_space(3))) const char* lds_cptr;
typedef short v4i16_t __attribute__((ext_vector_type(4)));
__device__ __forceinline__ void kload8(bf16x8*kf,lds_cptr kp){
  kf[0]=*(const __attribute__((address_space(3))) bf16x8*)(kp);      kf[1]=*(const __attribute__((address_space(3))) bf16x8*)(kp+512);
  kf[2]=*(const __attribute__((address_space(3))) bf16x8*)(kp+2048); kf[3]=*(const __attribute__((address_space(3))) bf16x8*)(kp+2560);
  kf[4]=*(const __attribute__((address_space(3))) bf16x8*)(kp+4096); kf[5]=*(const __attribute__((address_space(3))) bf16x8*)(kp+4608);
  kf[6]=*(const __attribute__((address_space(3))) bf16x8*)(kp+6144); kf[7]=*(const __attribute__((address_space(3))) bf16x8*)(kp+6656);
}
__device__ __forceinline__ void kload2(bf16x8*kf,lds_cptr kp,int j){ kf[2*j]=*(const __attribute__((address_space(3))) bf16x8*)(kp+j*2048); kf[2*j+1]=*(const __attribute__((address_space(3))) bf16x8*)(kp+j*2048+512); }
__device__ __forceinline__ s16x4 vtr(lds_cptr p){ return __builtin_bit_cast(s16x4,__builtin_amdgcn_ds_read_tr16_b64_v4i16((__attribute__((address_space(3))) v4i16_t*)p)); }
__device__ __forceinline__ float rowmax(const f32x16&p0,const f32x16&p1){
  float a=max3f(p0[0],p0[1],p1[0]),b=max3f(p0[2],p0[3],p1[1]);a=max3f(a,p1[2],p1[3]);
  #pragma unroll
  for(int r=4;r<16;r+=4){a=max3f(a,p0[r],p0[r+1]);b=max3f(b,p0[r+2],p0[r+3]);a=max3f(a,p1[r],p1[r+1]);b=max3f(b,p1[r+2],p1[r+3]);}
  const float m=max2f(a,b);
  auto rr=__builtin_amdgcn_permlane32_swap(__float_as_uint(m),__float_as_uint(m),false,false);
  return max2f(__uint_as_float(rr[0]),__uint_as_float(rr[1]));
}
__device__ __forceinline__ void pv(f32x16*o,int vb,bf16x8 pa0,bf16x8 pa1,bf16x8 pa2,bf16x8 pa3){
  #pragma unroll
  for(int d0=0;d0<2;++d0){s16x4 lo[4],hi[4];
    #pragma unroll
    for(int ks=0;ks<4;++ks){
      asm volatile("ds_read_b64_tr_b16 %0,%1 offset:%c2":"=&v"(lo[ks]):"v"(vb),"i"(d0*4096+ks*1024):"memory");
      asm volatile("ds_read_b64_tr_b16 %0,%1 offset:%c2":"=&v"(hi[ks]):"v"(vb),"i"(d0*4096+ks*1024+512):"memory");}
    asm volatile("s_waitcnt lgkmcnt(0)":::"memory");SBAR();
    #define PK(k) (bf16x8){lo[k][0],lo[k][1],lo[k][2],lo[k][3],hi[k][0],hi[k][1],hi[k][2],hi[k][3]}
    o[d0]=__builtin_amdgcn_mfma_f32_32x32x16_bf16(pa0,PK(0),o[d0],0,0,0);
    o[d0]=__builtin_amdgcn_mfma_f32_32x32x16_bf16(pa1,PK(1),o[d0],0,0,0);
    o[d0]=__builtin_amdgcn_mfma_f32_32x32x16_bf16(pa2,PK(2),o[d0],0,0,0);
    o[d0]=__builtin_amdgcn_mfma_f32_32x32x16_bf16(pa3,PK(3),o[d0],0,0,0);
    #undef PK
  }
}

#ifndef ATTN_STORE16
#define ATTN_STORE16(p,v) (*(u32x4*)(p)=(v))
#endif
template<int THRL> __device__ __forceinline__ void attn_unit(int qb,const bf16*Qb,const bf16*__restrict__ Kh,const bf16*__restrict__ Vh,bf16*Ob,char*shm){
  const int tid=threadIdx.x,lane=tid&63,r32=lane&31,hi=lane>>5; const int wid=__builtin_amdgcn_readfirstlane(tid>>6);
  const int q0=qb*QB;
  const bf16*Qw=Qb+(long)(q0+wid*QBLK)*DM;
  const unsigned lds0=(unsigned)(uintptr_t)shm;
  float*wsf=(float*)(shm+LDS_WS)+wid*64;
  const bf16*ksrc=Kh+(long)lane*DM+wid*8;
  const bf16*vsrc=Vh+(long)(16*(wid&3)+(lane>>2))*DM+(wid>>2)*32+(lane&3)*8;
  const unsigned kdst=lds0+LDS_K+wid*1024, vdst=lds0+LDS_V+wid*1024;
  #define DMA_K(t,slot) glds16(ksrc+(long)(t)*KVBLK*DM,(unsigned)__builtin_amdgcn_readfirstlane(kdst+(slot)))
  #define DMA_V(t,slot) glds16(vsrc+(long)(t)*KVBLK*DM,(unsigned)__builtin_amdgcn_readfirstlane(vdst+(slot)))
  const int vb0=(int)(lds0+LDS_V)+((lane>>4)&1)*32+(lane&3)*8+(4*hi+((lane&15)>>2))*64;
  const char*Kbase=shm+LDS_K; bf16x8 kf[8];
  const lds_cptr shm3=(lds_cptr)shm; const lds_cptr kp0=shm3+LDS_K+hi*1024+r32*16; const lds_cptr vp0=shm3+LDS_V+((lane>>4)&1)*32+(lane&3)*8+(4*hi+((lane&15)>>2))*64;
  const int NT=(q0+QB)/KVBLK;
  DMA_K(0,0);DMA_V(0,0);DMA_K(1,SLOTB);
  bf16x8 qr[4];
  #pragma unroll
  for(int d0=0;d0<4;++d0)qr[d0]=*reinterpret_cast<const bf16x8*>(&Qw[(long)r32*DM+d0*16+hi*8]);
  float mhat=0.f,l_reg=0.f;f32x16 o[2];o[0]=f32x16{};o[1]=f32x16{};f32x16 negm=f32x16{};asm volatile("":"+v"(negm));
  const int qrel=wid*QBLK+r32;
  #define CMASK(P0,P1,t) do{int jb_=(t)-(NT-4); if(jb_>=0)cmask(P0,P1,jb_,qrel,hi);}while(0)
  bool resc=false;
  #define START(P0,P1) do{ const float rm=rowmax(P0,P1); resc=false; \
    { const float dl=rm; mhat=fadd_s(mhat,dl); \
      _Pragma("unroll") for(int r=0;r<16;++r){P0[r]=fsub_s(P0[r],dl);P1[r]=fsub_s(P1[r],dl);} \
      _Pragma("unroll") for(int r=0;r<16;++r)negm[r]=-mhat; asm volatile("":"+v"(negm)); } \
    _Pragma("unroll") for(int r=0;r<16;++r)P0[r]=__builtin_amdgcn_exp2f(P0[r]); }while(0)
  #define RESC() do{ if(resc){ asm volatile("s_waitcnt lgkmcnt(0)":::"memory"); \
      _Pragma("unroll") for(int d_=0;d_<2;++d_) _Pragma("unroll") for(int r=0;r<16;++r)o[d_][r]*=wsf[crow(r,hi)]; } }while(0)
  f32x16 pA0,pA1,pB0,pB1;
  int sl_prev=0,sl_cur=0,sl_next=SLOTB;
  #define ROT() do{sl_prev=sl_cur;sl_cur=sl_next;sl_next=(sl_next==(NSLOT-1)*SLOTB)?0:sl_next+SLOTB;}while(0)
  DMA_K(2,2*SLOTB);
  WAIT_BAR(3);
  qkt(pA0,pA1,Kbase,qr,negm,r32,hi);asm volatile("s_nop 15\n\ts_nop 7":"+v"(pA0),"+v"(pA1));CMASK(pA0,pA1,0);
  START(pA0,pA1);
  _Pragma("unroll") for(int r=0;r<16;++r)pA1[r]=__builtin_amdgcn_exp2f(pA1[r]);
  WAIT_BAR(0);
  DMA_K(3,0);DMA_V(1,SLOTB);
  ROT();
  kload8(kf,kp0+sl_cur);
  WAIT_BAR(2);
  s16x4 vlo[8],vhi[8]; u32x4 pw0,pw1,pw2,pw3;
  #define PKW(P,B) cvtpk_s(P[B],P[B+1])
  #define PAF(k) __builtin_bit_cast(bf16x8,pw##k)
  #define VFR(i) (bf16x8){vlo[i][0],vlo[i][1],vlo[i][2],vlo[i][3],vhi[i][0],vhi[i][1],vhi[i][2],vhi[i][3]}
  #define PIN(x) asm volatile("":"+v"(x))
  #define MX3(a,b,c) __builtin_fmaxf(__builtin_fmaxf((a),(b)),(c))
  #define GAPA(MF,A0,A1,A2,A3,W0,W1,PW) do{ MF; sacc+=A0; sacc+=A1; sacc+=A2; sacc+=A3; PIN(sacc); W0; W1; PIN(PW); SBAR(); }while(0)
  #define EX(v) __builtin_amdgcn_exp2f(v)
  #define GAPB(MF,X,B) do{ MF; X[B]=EX(X[B]); X[B+1]=EX(X[B+1]); X[B+2]=EX(X[B+2]); X[B+3]=EX(X[B+3]); PIN(X); SBAR(); }while(0)
  #define VRD(i) do{ vlo[i]=vtr(vp_+(((i)>>2)*4096+((i)&3)*1024)); vhi[i]=vtr(vp_+(((i)>>2)*4096+((i)&3)*1024+512)); }while(0)
  #define KRD(G,j) do{ if(G){ kload2(kf,kp0+sl_next,j); SBAR(); } }while(0)
  #define STEP(C0,C1,P0,P1,t,GK,GV,GL) do{ SBAR(); \
    const lds_cptr vp_=vp0+sl_prev; \
    VRD(0); SBAR(); float sacc=(P0[0]+P0[1]); \
    GAPA(C0=__builtin_amdgcn_mfma_f32_32x32x16_bf16(kf[0],qr[0],negm,0,0,0), P0[2],P0[3],P0[4],P0[5],     pw0[0]=PKW(P0,0), pw0[1]=PKW(P0,2), pw0); \
    VRD(4); SBAR(); GAPA(C1=__builtin_amdgcn_mfma_f32_32x32x16_bf16(kf[1],qr[0],negm,0,0,0), P0[6],P0[7],P0[8],P0[9],     pw0[2]=PKW(P0,4), pw0[3]=PKW(P0,6), pw0); \
    VRD(1); SBAR(); GAPA(C0=__builtin_amdgcn_mfma_f32_32x32x16_bf16(kf[2],qr[1],C0,0,0,0),   P0[10],P0[11],P0[12],P0[13], pw1[0]=PKW(P0,8), pw1[1]=PKW(P0,10), pw1); \
    VRD(5); SBAR(); GAPA(C1=__builtin_amdgcn_mfma_f32_32x32x16_bf16(kf[3],qr[1],C1,0,0,0),   P0[14],P0[15],P1[0],P1[1],   pw1[2]=PKW(P0,12),pw1[3]=PKW(P0,14), pw1); \
    VRD(2); SBAR(); GAPA(C0=__builtin_amdgcn_mfma_f32_32x32x16_bf16(kf[4],qr[2],C0,0,0,0),   P1[2],P1[3],P1[4],P1[5],     pw2[0]=PKW(P1,0), pw2[1]=PKW(P1,2), pw2); \
    VRD(6); SBAR(); GAPA(C1=__builtin_amdgcn_mfma_f32_32x32x16_bf16(kf[5],qr[2],C1,0,0,0),   P1[6],P1[7],P1[8],P1[9],     pw2[2]=PKW(P1,4), pw2[3]=PKW(P1,6), pw2); \
    VRD(3); SBAR(); GAPA(C0=__builtin_amdgcn_mfma_f32_32x32x16_bf16(kf[6],qr[3],C0,0,0,0),   P1[10],P1[11],P1[12],P1[13], pw3[0]=PKW(P1,8), pw3[1]=PKW(P1,10), pw3); \
    VRD(7); SBAR(); GAPA(C1=__builtin_amdgcn_mfma_f32_32x32x16_bf16(kf[7],qr[3],C1,0,0,0),   P1[14],P1[15],0.f,0.f,       pw3[2]=PKW(P1,12),pw3[3]=PKW(P1,14), pw3); \
    l_reg+=sacc; \
    if(GK){DMA_K((t)+3,sl_cur);} if(GV){DMA_V((t)+1,sl_next);} \
    CMASK(C0,C1,t); \
    { float a=MX3(C0[0],C0[1],C1[0]),b=MX3(C0[2],C0[3],C1[1]); a=MX3(a,C1[2],C1[3]); \
      _Pragma("unroll") for(int r=4;r<16;r+=4){a=MX3(a,C0[r],C0[r+1]);b=MX3(b,C0[r+2],C0[r+3]);a=MX3(a,C1[r],C1[r+1]);b=MX3(b,C1[r+2],C1[r+3]);} \
      float rm=__builtin_fmaxf(a,b); { auto rr=__builtin_amdgcn_permlane32_swap(__float_as_uint(rm),__float_as_uint(rm),false,false); rm=__builtin_fmaxf(__uint_as_float(rr[0]),__uint_as_float(rr[1])); } \
      resc=false; \
      if(__builtin_expect(__any(rm>(float)THRL),0)){ const float dl=__builtin_fmaxf(rm,0.f); mhat+=dl; \
        _Pragma("unroll") for(int r=0;r<16;++r){C0[r]-=dl;C1[r]-=dl;} \
        _Pragma("unroll") for(int r=0;r<16;++r)negm[r]=-mhat; asm volatile("":"+v"(negm)); \
        const float f=__builtin_amdgcn_exp2f(-dl); l_reg*=f; if(hi==0)wsf[r32]=f; resc=true; } } \
    SBAR(); \
    GAPB(o[0]=__builtin_amdgcn_mfma_f32_32x32x16_bf16(PAF(0),VFR(0),o[0],0,0,0), C0,0); \
    GAPB(o[1]=__builtin_amdgcn_mfma_f32_32x32x16_bf16(PAF(0),VFR(4),o[1],0,0,0), C0,4); \
    KRD(GL,0); GAPB(o[0]=__builtin_amdgcn_mfma_f32_32x32x16_bf16(PAF(1),VFR(1),o[0],0,0,0), C0,8); \
    KRD(GL,1); GAPB(o[1]=__builtin_amdgcn_mfma_f32_32x32x16_bf16(PAF(1),VFR(5),o[1],0,0,0), C0,12); \
    KRD(GL,2); GAPB(o[0]=__builtin_amdgcn_mfma_f32_32x32x16_bf16(PAF(2),VFR(2),o[0],0,0,0), C1,0); \
    KRD(GL,3); GAPB(o[1]=__builtin_amdgcn_mfma_f32_32x32x16_bf16(PAF(2),VFR(6),o[1],0,0,0), C1,4); \
    GAPB(o[0]=__builtin_amdgcn_mfma_f32_32x32x16_bf16(PAF(3),VFR(3),o[0],0,0,0), C1,8); \
    GAPB(o[1]=__builtin_amdgcn_mfma_f32_32x32x16_bf16(PAF(3),VFR(7),o[1],0,0,0), C1,12); \
    }while(0)
  int t=1;
  #undef CMASK
  #define CMASK(P0,P1,t) do{}while(0)
  for(;t+5<NT;t+=2){
    STEP(pB0,pB1,pA0,pA1,t,true,true,true);     WAIT_BAR(2); RESC(); ROT();
    STEP(pA0,pA1,pB0,pB1,t+1,true,true,true);   WAIT_BAR(2); RESC(); ROT();
  }
  #undef CMASK
  #define CMASK(P0,P1,t) do{int jb_=(t)-(NT-4); if(jb_>=0)cmask(P0,P1,jb_,qrel,hi);}while(0)
  #define ENDW(tt) do{ if((tt)+3<NT){WAIT_BAR(2);} else if((tt)+2<NT){WAIT_BAR(1);} else {WAIT_BAR(0);} }while(0)
  for(;t+1<NT;t+=2){
    STEP(pB0,pB1,pA0,pA1,t,(t+3<NT),(t+1<NT),(t+1<NT));       ENDW(t);   RESC(); ROT();
    STEP(pA0,pA1,pB0,pB1,t+1,(t+4<NT),(t+2<NT),(t+2<NT));     ENDW(t+1); RESC(); ROT();
  }
  STEP(pB0,pB1,pA0,pA1,NT-1,false,false,false); RESC();
  { float sacc=pB0[0]+pB0[1]; _Pragma("unroll") for(int r=2;r<16;++r)sacc+=pB0[r]; _Pragma("unroll") for(int r=0;r<16;++r)sacc+=pB1[r]; l_reg+=sacc;
    pw0=(u32x4){PKW(pB0,0),PKW(pB0,2),PKW(pB0,4),PKW(pB0,6)};pw1=(u32x4){PKW(pB0,8),PKW(pB0,10),PKW(pB0,12),PKW(pB0,14)};pw2=(u32x4){PKW(pB1,0),PKW(pB1,2),PKW(pB1,4),PKW(pB1,6)};pw3=(u32x4){PKW(pB1,8),PKW(pB1,10),PKW(pB1,12),PKW(pB1,14)};
    SBAR(); pv(o,vb0+sl_cur,PAF(0),PAF(1),PAF(2),PAF(3)); }
  #undef PKW
  #undef PAF
  #undef VFR
  #undef PIN
  #undef MX3
  #undef GAPA
  #undef GAPB
  #undef EX
  #undef VRD
  #undef KRD
  #undef STEP
  #undef ENDW
  {auto rr=__builtin_amdgcn_permlane32_swap(__float_as_uint(l_reg),__float_as_uint(l_reg),false,false);l_reg=__uint_as_float(rr[0])+__uint_as_float(rr[1]);}
  if(hi==0)wsf[32+r32]=l_reg;asm volatile("s_waitcnt lgkmcnt(0)":::"memory");
  float rli[16];
  #pragma unroll
  for(int r=0;r<16;++r)rli[r]=__builtin_amdgcn_rcpf(wsf[32+crow(r,hi)]);
  bf16*Ow=Ob+(long)(q0+wid*QBLK)*DMO;
  { bf16*stg=(bf16*)(shm+LDS_OST)+wid*2048;
    #pragma unroll
    for(int r=0;r<16;++r){const int orow=crow(r,hi);
      #pragma unroll
      for(int d0=0;d0<2;++d0)stg[orow*64+d0*32+r32]=__float2bfloat16(o[d0][r]*rli[r]);}
    asm volatile("s_waitcnt lgkmcnt(0)":::"memory");
    #pragma unroll
    for(int i=0;i<4;++i){const int row=i*8+(lane>>3),ch=lane&7; const u32x4 v=*(const u32x4*)(stg+row*64+ch*8); ATTN_STORE16(Ow+(long)row*DMO+ch*8,v);} }
  asm volatile("s_waitcnt lgkmcnt(0)\n\ts_barrier":::"memory");
  #undef DMA_K
  #undef DMA_V
  #undef CMASK
  #undef START
  #undef RESC
  #undef ROT
}
constexpr int ATTN_LDS_BYTES=LDS_BYTES;
struct AttnTensors { const bf16* Q; const bf16* K; const bf16* V; bf16* O; };
struct AttnUnit { int bh; int qb; };
struct StaticOrder {
  int vcu;
  __device__ __forceinline__ explicit StaticOrder(int vcu_):vcu(vcu_){}
  __device__ __forceinline__ bool next(int i,AttnUnit&u)const{ if(i>=8)return false; const int s=(vcu&1)+2*(i>>1); u.bh=vcu>>1; u.qb=(i&1)?15-s:s; return true; }
  __device__ __forceinline__ void a_ready(const AttnUnit&)const{}
  __device__ __forceinline__ void done(const AttnUnit&)const{}
};
template<class Sched,int THRL=8> __device__ __forceinline__ void attn_phase(char*lds,const AttnTensors&T,const Sched&S){
  AttnUnit u;
  for(int i=0;S.next(i,u);++i){ S.a_ready(u); const int b=u.bh>>4,vh=u.bh&15;
    const long rb=(long)b*SEQ;
    attn_unit<THRL>(u.qb,T.Q+rb*DM+(vh>>1)*64,T.K+rb*DM+512+(vh>>1)*64,T.V+rb*DM+1024+(vh>>2)*128+(vh&1)*64,T.O+rb*DMO+vh*64,lds); S.done(u); }
}
#undef SBAR
#undef WAIT_BAR
}
namespace mk {
#define LAS __attribute__((address_space(3)))
typedef unsigned short bf16_t;
typedef short bf16x8 __attribute__((ext_vector_type(8)));
typedef float f32x4 __attribute__((ext_vector_type(4)));
typedef float f32x2 __attribute__((ext_vector_type(2)));
typedef float f32x16 __attribute__((ext_vector_type(16)));
typedef unsigned u32x4 __attribute__((ext_vector_type(4)));
typedef unsigned u32x2 __attribute__((ext_vector_type(2)));
typedef short v4i16_t __attribute__((ext_vector_type(4)));

constexpr int M = 32768, SEQ = 4096, DMODEL = 1024, DFF = 4096, NWAVES = 8, NTHREADS = 512;
constexpr float EPS = 1e-6f, LOG2E = 1.4426950408889634f, LN2 = 0.6931471805599453f;
constexpr float QSCALE = 0.125f * LOG2E;
constexpr float CSCALE2 = 0.10206207261596577f * LOG2E;
constexpr int CQ = 4608;

constexpr size_t MiB = 1u << 20;
constexpr size_t WS_WAB = 1 * MiB, WS_WOAB = 7 * MiB, WS_WMI = 9 * MiB, WS_WMO = 25 * MiB, WS_WPP = 41 * MiB, WS_WPG = 42 * MiB, WS_WC = 46 * MiB;
constexpr size_t WS_WQI = 48 * MiB, WS_WQF = 48 * MiB + 512 * 1024, WS_WCOMB = 52 * MiB, WS_CS64 = 61 * MiB, WS_CS32 = 62 * MiB;
constexpr size_t WS_XN = 64 * MiB, WS_BIG = 128 * MiB, WS_HI = 384 * MiB, WS_END = 512 * MiB;
constexpr size_t WS_QKV = WS_BIG, WS_OA = WS_HI, WS_CAT = WS_HI + 64 * MiB, WS_Y0 = WS_BIG, WS_HID = WS_BIG, WS_Y2 = WS_HI, WS_PBF = WS_BIG, WS_PLE = WS_BIG + 16 * MiB;
constexpr size_t WS_CIN = WS_BIG, WS_CQN = WS_HI, WS_KV = WS_HI + 24 * MiB, WS_KI = WS_HI + 42 * MiB, WS_WI = WS_HI + 46 * MiB, WS_IDX = WS_HI + 47 * MiB;
constexpr size_t WS_QI = 352 * MiB, WS_SCR = WS_BIG, WS_QF = 64 * MiB, WS_Y1 = WS_HI;
constexpr size_t OUT_LSE_OFF = 96 * MiB;

constexpr int LDS_BYTES = 155648;

__device__ __forceinline__ unsigned f2bf(float f) { unsigned u = __builtin_bit_cast(unsigned, f); return (u + 0x7fffu + ((u >> 16) & 1u)) >> 16; }
__device__ __forceinline__ unsigned pk2(float lo, float hi) { return f2bf(lo) | (f2bf(hi) << 16); }
__device__ __forceinline__ float bf2f(unsigned short b) { return __builtin_bit_cast(float, (unsigned)b << 16); }
__device__ __forceinline__ float bflo(unsigned w) { return __builtin_bit_cast(float, w << 16); }
__device__ __forceinline__ float bfhi(unsigned w) { return __builtin_bit_cast(float, w & 0xffff0000u); }
__device__ __forceinline__ float wave_sum(float v) {
#pragma unroll
    for (int o = 1; o < 64; o <<= 1) v += __shfl_xor(v, o);
    return v;
}
__device__ __forceinline__ float half_sum(float v) {
#pragma unroll
    for (int o = 1; o < 32; o <<= 1) v += __shfl_xor(v, o);
    return v;
}
__device__ __forceinline__ int lanes_below(unsigned long long mask) { return (int)__builtin_amdgcn_mbcnt_hi((unsigned)(mask >> 32), __builtin_amdgcn_mbcnt_lo((unsigned)mask, 0u)); }
__device__ __forceinline__ bf16x8 tr8(const LAS unsigned char* p0, const LAS unsigned char* p1) {
    const v4i16_t lo = __builtin_amdgcn_ds_read_tr16_b64_v4i16((LAS v4i16_t*)p0);
    const v4i16_t hi = __builtin_amdgcn_ds_read_tr16_b64_v4i16((LAS v4i16_t*)p1);
    return (bf16x8){lo[0], lo[1], lo[2], lo[3], hi[0], hi[1], hi[2], hi[3]};
}
#define LDS_WAIT() asm volatile("s_waitcnt lgkmcnt(0)" ::: "memory")
#define VM_WAIT() asm volatile("s_waitcnt vmcnt(0)" ::: "memory")

#define GAS __attribute__((address_space(1)))
typedef GAS unsigned gu32;
typedef GAS unsigned long long gu64;
#define RLX_AGENT __ATOMIC_RELAXED, __HIP_MEMORY_SCOPE_AGENT
__device__ __forceinline__ unsigned long long rt() { return __builtin_amdgcn_s_memrealtime(); }

#define XB_TMO      128
#define XB_XCNT(j)  (256  + 64 * (j))
#define XB_XSUB(j)  (1280 + 64 * (j))
#define XB_XGEN(j)  (2304 + 64 * (j))
#define XB_TOP      3328
#define XB_TOPGEN   3392
#define XCD_BAR_WORDS 3456
#define XB_SPIN_CAP (1u << 24)

__device__ __forceinline__ unsigned xb_ld(unsigned* p)              { return __hip_atomic_load(p, __ATOMIC_RELAXED, __HIP_MEMORY_SCOPE_AGENT); }
__device__ __forceinline__ unsigned xb_add(unsigned* p, unsigned v) { return __hip_atomic_fetch_add(p, v, __ATOMIC_RELAXED, __HIP_MEMORY_SCOPE_AGENT); }
__device__ __forceinline__ unsigned xb_xcc_id() { return (unsigned)__builtin_amdgcn_s_getreg((3 << 11) | 20) & 0xFu; }
#define XB_SPIN(cond, bar) do { unsigned _sp = 0; while (cond) { __builtin_amdgcn_s_sleep(1); \
    if ((++_sp & 255u) == 0u) { if (xb_ld(&(bar)[XB_TMO])) break; if (_sp > XB_SPIN_CAP) { atomicAdd(&(bar)[XB_TMO], 1u); break; } } } } while (0)

struct XcdBarrier {
    unsigned* bar; unsigned x;
    volatile LAS unsigned* st;
};

__device__ __forceinline__ XcdBarrier xcd_barrier_post(unsigned* bar, volatile LAS unsigned* st, bool leader) {
    XcdBarrier b; b.bar = bar; b.x = xb_xcc_id(); b.st = st;
    if (leader) (void)xb_add(&bar[XB_XCNT(b.x)], 1u);
    return b;
}
__device__ __forceinline__ void xcd_barrier_complete(unsigned* bar, unsigned x, unsigned& nloc, unsigned& nx) {
    const unsigned G = gridDim.x * gridDim.y * gridDim.z;
    unsigned sum, cnt, mine, sp = 0u;
    for (;;) {
        sum = 0u; cnt = 0u; mine = 0u;
#pragma unroll
        for (unsigned j = 0; j < 16; ++j) { const unsigned c = xb_ld(&bar[XB_XCNT(j)]); sum += c; cnt += (c > 0u) ? 1u : 0u; mine = (j == x) ? c : mine; }
        if (sum == G) break;
        __builtin_amdgcn_s_sleep(1);
        if ((++sp & 255u) == 0u) { if (xb_ld(&bar[XB_TMO])) break; if (sp > XB_SPIN_CAP) { atomicAdd(&bar[XB_TMO], 1u); break; } }
    }
    nloc = mine > 0u ? mine : 1u; nx = cnt > 0u ? cnt : 1u;
}

__device__ __forceinline__ void xcd_barrier(const XcdBarrier& b, bool leader) {
    asm volatile("s_waitcnt vmcnt(0)" ::: "memory");
    __syncthreads();
    if (leader) {
        unsigned* bar = b.bar;
        __builtin_amdgcn_s_waitcnt(0);
        unsigned nloc = b.st[0], nx = b.st[1];
        if (nloc == 0u) { xcd_barrier_complete(bar, b.x, nloc, nx); b.st[0] = nloc; b.st[1] = nx; }
        const unsigned old = xb_add(&bar[XB_XSUB(b.x)], 1u);
        const unsigned gen = old / nloc;
        if (old + 1u == (gen + 1u) * nloc) {
            __builtin_amdgcn_fence(__ATOMIC_RELEASE, "agent");
            asm volatile("s_waitcnt vmcnt(0)" ::: "memory");
            const unsigned og = xb_add(&bar[XB_TOP], 1u);
            const unsigned tg = og / nx;
            if (og + 1u == (tg + 1u) * nx) xb_add(&bar[XB_TOPGEN], 1u);
            else XB_SPIN(xb_ld(&bar[XB_TOPGEN]) == tg, bar);
            __builtin_amdgcn_fence(__ATOMIC_ACQUIRE, "agent");
            xb_add(&bar[XB_XGEN(b.x)], 1u);
            asm volatile("s_waitcnt vmcnt(0)" ::: "memory");
        } else {
            XB_SPIN(xb_ld(&bar[XB_XGEN(b.x)]) == gen, bar);
            __builtin_amdgcn_fence(__ATOMIC_ACQUIRE, "agent");
            asm volatile("s_waitcnt vmcnt(0)" ::: "memory");
        }
    }
    __syncthreads();
}

struct Args {
    const float* in[25];
    float* OUTF; unsigned char* WSF;
    int ph_lo, ph_hi;
};

__device__ __forceinline__ void transpose_item(const float* W, int K, int N, bf16_t* WT, LAS float* scr, int item, int lane) {
    const int nblk = N / 32, kb = item / nblk, nb = item % nblk, k0 = 64 * kb, n0 = 32 * nb;
#pragma unroll 8
    for (int i = 0; i < 32; ++i) { const int kk = 2 * i + (lane >> 5); scr[kk * 33 + (lane & 31)] = W[(size_t)(k0 + kk) * N + n0 + (lane & 31)]; }
    LDS_WAIT();
    const int c = lane & 7;
#pragma unroll
    for (int j = 0; j < 4; ++j) { const int n = (lane >> 3) + 8 * j; const LAS float* s = scr + (8 * c) * 33 + n;
        u32x4 o; o.x = pk2(s[0 * 33], s[1 * 33]); o.y = pk2(s[2 * 33], s[3 * 33]); o.z = pk2(s[4 * 33], s[5 * 33]); o.w = pk2(s[6 * 33], s[7 * 33]);
        *(u32x4*)(WT + (size_t)(n0 + n) * K + k0 + 8 * c) = o; }
    LDS_WAIT();
}
__device__ __forceinline__ void rms_row_to_bf16(const float* xrow, const float* g, bf16_t* orow, int lane) {
    const f32x4* xr = (const f32x4*)xrow + lane; const f32x4* gr = (const f32x4*)g + lane;
    f32x4 v[4]; float s = 0.f;
#pragma unroll
    for (int j = 0; j < 4; ++j) { v[j] = xr[64 * j]; s += (v[j].x * v[j].x + v[j].y * v[j].y) + (v[j].z * v[j].z + v[j].w * v[j].w); }
    const float r = rsqrtf(wave_sum(s) * (1.f / 1024.f) + EPS);
    unsigned long long* o8 = (unsigned long long*)orow + lane;
#pragma unroll
    for (int j = 0; j < 4; ++j) { const f32x4 gg = gr[64 * j]; const f32x4 o = v[j] * r * gg;
        o8[64 * j] = (unsigned long long)pk2(o.x, o.y) | ((unsigned long long)pk2(o.z, o.w) << 32); }
}
template <bool NORM>
__device__ __forceinline__ void post_row(const float* yrow, const float* rrow, float* hrow, const float* gpost, const float* gpre, bf16_t* xnrow, int lane) {
    const f32x4* yr = (const f32x4*)yrow + lane; const f32x4* rr = (const f32x4*)rrow + lane; const f32x4* gp = (const f32x4*)gpost + lane;
    f32x4 v[4]; float s = 0.f;
#pragma unroll
    for (int j = 0; j < 4; ++j) { v[j] = yr[64 * j]; s += (v[j].x * v[j].x + v[j].y * v[j].y) + (v[j].z * v[j].z + v[j].w * v[j].w); }
    const float r = rsqrtf(wave_sum(s) * (1.f / 1024.f) + EPS);
    float s2 = 0.f;
#pragma unroll
    for (int j = 0; j < 4; ++j) { v[j] = rr[64 * j] + v[j] * r * gp[64 * j]; s2 += (v[j].x * v[j].x + v[j].y * v[j].y) + (v[j].z * v[j].z + v[j].w * v[j].w); }
    f32x4* ho = (f32x4*)hrow + lane;
#pragma unroll
    for (int j = 0; j < 4; ++j) ho[64 * j] = v[j];
    float r2 = 1.f;
    if (NORM) r2 = rsqrtf(wave_sum(s2) * (1.f / 1024.f) + EPS);
    unsigned long long* o8 = (unsigned long long*)xnrow + lane;
#pragma unroll
    for (int j = 0; j < 4; ++j) { f32x4 o = v[j] * r2; if (NORM) o = o * ((const f32x4*)gpre + lane)[64 * j];
        o8[64 * j] = (unsigned long long)pk2(o.x, o.y) | ((unsigned long long)pk2(o.z, o.w) << 32); }
}

constexpr int DV_PITCH = 144;
__device__ __forceinline__ void dilated_unit(int u, const bf16_t* qkv, bf16_t* OB, float* LSE, LAS unsigned char* lds, int tid, int wid, int lane) {
    const int bh = u / 96, r = u % 96, br = r >> 5, rr = r & 31;
    const int b = bh >> 3, h = bh & 7;
    const int dil = br == 0 ? 1 : (br == 1 ? 4 : 16), lnb = br == 0 ? 5 : (br == 1 ? 3 : 1);
    const int c = rr >> lnb, nblk = rr & ((1 << lnb) - 1);
    const size_t rowb = (size_t)b * SEQ;
    {
        const int kk = tid >> 1, half = tid & 1, nk = (nblk - 1) * 128 + kk;
        u32x4 v[4];
#pragma unroll
        for (int i = 0; i < 4; ++i) v[i] = (u32x4){0u, 0u, 0u, 0u};
        if (nk >= 0) { const u32x4* src = (const u32x4*)(qkv + (rowb + (size_t)nk * dil + c) * 3072 + 2560 + h * 64 + half * 32);
#pragma unroll
            for (int i = 0; i < 4; ++i) v[i] = src[i]; }
        LAS unsigned char* dst = lds + kk * DV_PITCH + half * 64;
#pragma unroll
        for (int i = 0; i < 4; ++i) *(LAS u32x4*)(dst + 16 * i) = v[i];
        if (tid < 128) *(LAS u32x4*)(lds + (256 + (tid >> 3)) * DV_PITCH + (tid & 7) * 16) = (u32x4){0u, 0u, 0u, 0u};
    }
    __syncthreads();
    const int fr = lane & 15, g = lane >> 4;
    const int qi = 16 * wid + fr, tq = (nblk * 128 + qi) * dil + c;
    const bf16_t* qrow = qkv + (rowb + tq) * 3072 + 1536 + h * 64;
    bf16x8 qf[2];
#pragma unroll
    for (int ks = 0; ks < 2; ++ks) qf[ks] = *(const bf16x8*)(qrow + ks * 32 + g * 8);
    f32x4 oacc[4];
#pragma unroll
    for (int mt = 0; mt < 4; ++mt) oacc[mt] = (f32x4){0.f, 0.f, 0.f, 0.f};
    float mrun = -1e30f, lrun = 0.f;
    const int kmin = nblk > 0 ? 0 : 128;
#pragma unroll 1
    for (int ch = 0; ch < 5; ++ch) {
        const int kk0 = 16 * wid + 32 * ch;
        int klo = qi > kmin ? qi : kmin; asm volatile("" : "+v"(klo));
        const unsigned kspan = (unsigned)(qi + 128 - klo);
        f32x4 s[2];
#pragma unroll
        for (int tt = 0; tt < 2; ++tt) {
            const int kk = kk0 + 16 * tt + fr, nk = (nblk - 1) * 128 + kk;
            const int pos = (nk >= 0 && kk < 256) ? nk * dil + c : tq;
            const bf16_t* krow = qkv + (rowb + pos) * 3072 + 2048 + h * 64;
            const bf16x8 a0 = *(const bf16x8*)(krow + g * 8), a1 = *(const bf16x8*)(krow + 32 + g * 8);
            s[tt] = __builtin_amdgcn_mfma_f32_16x16x32_bf16(a0, qf[0], (f32x4){0.f, 0.f, 0.f, 0.f}, 0, 0, 0);
            s[tt] = __builtin_amdgcn_mfma_f32_16x16x32_bf16(a1, qf[1], s[tt], 0, 0, 0);
        }
        float mx = -INFINITY;
#pragma unroll
        for (int tt = 0; tt < 2; ++tt)
#pragma unroll
            for (int e = 0; e < 4; ++e) { const int kk = kk0 + 16 * tt + 4 * g + e;
                const bool ok = (unsigned)(kk - klo) <= kspan;
                s[tt][e] = ok ? s[tt][e] : -INFINITY; mx = fmaxf(mx, s[tt][e]); }
        mx = fmaxf(mx, __shfl_xor(mx, 16)); mx = fmaxf(mx, __shfl_xor(mx, 32));
        const float mnew = fmaxf(mrun, mx), alpha = __builtin_amdgcn_exp2f(mrun - mnew);
        float ps = 0.f;
#pragma unroll
        for (int tt = 0; tt < 2; ++tt)
#pragma unroll
            for (int e = 0; e < 4; ++e) { s[tt][e] = __builtin_amdgcn_exp2f(s[tt][e] - mnew); ps += s[tt][e]; }
        ps += __shfl_xor(ps, 16); ps += __shfl_xor(ps, 32);
        lrun = lrun * alpha + ps; mrun = mnew;
        u32x4 pw; pw.x = pk2(s[0][0], s[0][1]); pw.y = pk2(s[0][2], s[0][3]); pw.z = pk2(s[1][0], s[1][1]); pw.w = pk2(s[1][2], s[1][3]);
        const bf16x8 pf = __builtin_bit_cast(bf16x8, pw);
        const LAS unsigned char* vb = lds + (kk0 + 4 * g + (fr >> 2)) * DV_PITCH + (fr & 3) * 8;
#pragma unroll
        for (int mt = 0; mt < 4; ++mt) {
            const bf16x8 vf = tr8(vb + mt * 32, vb + 16 * DV_PITCH + mt * 32);
            oacc[mt] = oacc[mt] * alpha;
            oacc[mt] = __builtin_amdgcn_mfma_f32_16x16x32_bf16(vf, pf, oacc[mt], 0, 0, 0);
        }
    }
    const float inv = 1.0f / lrun;
    const size_t tok = rowb + tq;
    bf16_t* orow = OB + ((size_t)br * M + tok) * 512 + h * 64;
#pragma unroll
    for (int mt = 0; mt < 4; ++mt) { u32x2 w; w.x = pk2(oacc[mt][0] * inv, oacc[mt][1] * inv); w.y = pk2(oacc[mt][2] * inv, oacc[mt][3] * inv);
        *(u32x2*)(orow + 16 * mt + 4 * g) = w; }
    if (g == 0) LSE[((size_t)br * M + tok) * 8 + h] = (mrun + __builtin_amdgcn_logf(lrun)) * LN2;
    __syncthreads();
}

__device__ __forceinline__ void topk_row(const float* srow, int t, int* idxrow, int lane) {
    const int nk = t + 1;
    if (nk <= 256) {
#pragma unroll
        for (int r = 0; r < 4; ++r) { const int j = lane + 64 * r; idxrow[j] = (j < nk) ? j : 0; }
        return;
    }
    unsigned u[64];
#pragma unroll
    for (int i = 0; i < 64; ++i) { const int key = lane + 64 * i; const unsigned bits = __builtin_bit_cast(unsigned, srow[key]);
        const unsigned mu = bits ^ ((unsigned)((int)bits >> 31) | 0x80000000u);
        u[i] = mu & (unsigned)((key - nk) >> 31); }
    unsigned T = 0u;
    for (int bit = 31; bit >= 0; --bit) {
        const unsigned cand = T | (1u << bit);
        int cnt = 0;
#pragma unroll
        for (int i0 = 0; i0 < 64; i0 += 8) {
            unsigned cg_ = cand; asm volatile("" : "+s"(cg_), "+s"(cnt));
#pragma unroll
            for (int i = i0; i < i0 + 8; ++i) cnt += __builtin_popcountll(__ballot(u[i] >= cg_)); }
        if (cnt >= 256) T = cand;
    }
    int cgt = 0;
#pragma unroll
    for (int i0 = 0; i0 < 64; i0 += 8) {
        unsigned tg_ = T; asm volatile("" : "+s"(tg_), "+s"(cgt));
#pragma unroll
        for (int i = i0; i < i0 + 8; ++i) cgt += __builtin_popcountll(__ballot(u[i] > tg_)); }
    const int rem = 256 - cgt;
    int base = 0, eqb = 0; unsigned Te = T;
#pragma unroll
    for (int i = 0; i < 64; ++i) {
        if ((i & 3) == 0) asm volatile("" : "+s"(Te), "+s"(base), "+s"(eqb));
        const bool gt = u[i] > Te, eq = u[i] == Te;
        const unsigned long long meq = __ballot(eq);
        const bool sel = gt || (eq && (eqb + lanes_below(meq)) < rem);
        const unsigned long long ms = __ballot(sel);
        if (sel) idxrow[base + lanes_below(ms)] = lane + 64 * i;
        base += __builtin_popcountll(ms); eqb += __builtin_popcountll(meq);
    }
}
__device__ __forceinline__ void indexer_unit(int b, int q4, const bf16_t* QI, const bf16_t* KI, const float* WI, const f32x2* CS32, float* scr, int* IDX, int lane) {
    const int t0 = q4 * 4; const size_t m0 = (size_t)b * SEQ + t0;
    const int rho = lane & 31, hf8 = lane >> 5;
    const int h = (rho & 3) + 4 * ((rho >> 3) & 1), ql = 2 * ((rho >> 2) & 1) + (rho >> 4);
    const bf16_t* qrow = QI + (m0 + ql) * 512 + h * 64;
    bf16x8 a[4];
#pragma unroll
    for (int ks = 0; ks < 4; ++ks) a[ks] = *(const bf16x8*)(qrow + 16 * ks + 8 * hf8);
    {
        const f32x2* cs = CS32 + (size_t)(t0 + ql) * 16 + 8 * hf8;
#pragma unroll
        for (int e = 0; e < 8; ++e) { const f32x2 c = cs[e]; const float x1 = bf2f((unsigned short)a[0][e]), x2 = bf2f((unsigned short)a[1][e]);
            a[0][e] = (short)f2bf(x1 * c.x - x2 * c.y); a[1][e] = (short)f2bf(x1 * c.y + x2 * c.x); }
    }
    float w[2][8];
#pragma unroll
    for (int qq = 0; qq < 2; ++qq) { const f32x4* wp = (const f32x4*)(WI + (m0 + 2 * hf8 + qq) * 8); const f32x4 w0 = wp[0], w1 = wp[1];
        w[qq][0] = w0.x; w[qq][1] = w0.y; w[qq][2] = w0.z; w[qq][3] = w0.w; w[qq][4] = w1.x; w[qq][5] = w1.y; w[qq][6] = w1.z; w[qq][7] = w1.w; }
    const bf16_t* kbase = KI + (size_t)b * SEQ * 64;
    const int ntile = ((t0 + 3) >> 5) + 1;
    for (int kt = 0; kt < ntile; ++kt) {
        const bf16_t* krow = kbase + (size_t)(kt * 32 + rho) * 64 + 8 * hf8;
        f32x16 c;
#pragma unroll
        for (int e = 0; e < 16; ++e) c[e] = 0.f;
#pragma unroll
        for (int ks = 0; ks < 4; ++ks) { const bf16x8 bb = *(const bf16x8*)(krow + 16 * ks); c = __builtin_amdgcn_mfma_f32_32x32x16_bf16(a[ks], bb, c, 0, 0, 0); }
#pragma unroll
        for (int qq = 0; qq < 2; ++qq) { float s = 0.f;
#pragma unroll
            for (int hh = 0; hh < 8; ++hh) s += w[qq][hh] * fmaxf(c[8 * qq + hh], 0.f);
            scr[(2 * hf8 + qq) * 4096 + kt * 32 + rho] = s; }
    }
    VM_WAIT();
    for (int q = 0; q < 4; ++q) topk_row(scr + q * 4096, t0 + q, IDX + (m0 + q) * 256, lane);
}

constexpr int SP_PITCH = 592, SP_BUF = 32 * SP_PITCH;
__device__ __forceinline__ void sparse_query(bf16_t* qrow  , const bf16_t* kvb, const int* idxm, int nvalid, LAS unsigned char* buf, int lane) {
    const int fr = lane & 15, g = lane >> 4;
    bf16x8 qf[9];
#pragma unroll
    for (int ks = 0; ks < 9; ++ks) qf[ks] = *(const bf16x8*)(qrow + fr * 288 + ks * 32 + g * 8);
    f32x4 oacc[16];
#pragma unroll
    for (int mt = 0; mt < 16; ++mt) oacc[mt] = (f32x4){0.f, 0.f, 0.f, 0.f};
    float mrun = -1e30f, lrun = 0.f;
    const int nch = (nvalid + 31) >> 5;
    for (int ch = 0; ch < nch; ++ch) {
        { const int jv = ch * 32 + (lane & 31); const int idxv = (jv < nvalid) ? idxm[jv] : 0;
          const unsigned char* gsrc = (const unsigned char*)kvb + (lane & 31) * 16; LAS unsigned char* ldst = buf + (lane >> 5) * SP_PITCH + (lane & 31) * 16;
#pragma unroll
          for (int hb = 0; hb < 4; ++hb) {
#pragma unroll
            for (int i = 4 * hb; i < 4 * hb + 4; ++i) { const int key = __shfl(idxv, 2 * i + (lane >> 5));
                const u32x4 v = *(const u32x4*)(gsrc + (size_t)key * 576);
                *(LAS u32x4*)(ldst + i * (2 * SP_PITCH)) = v; }
            asm volatile("" ::: "memory"); }
          const unsigned char* gsrc2 = (const unsigned char*)kvb + 512 + (lane & 3) * 16; LAS unsigned char* ldst2 = buf + (lane >> 2) * SP_PITCH + 512 + (lane & 3) * 16;
#pragma unroll
          for (int r = 0; r < 2; ++r) { const int key = __shfl(idxv, 16 * r + (lane >> 2));
              const u32x4 v = *(const u32x4*)(gsrc2 + (size_t)key * 576);
              *(LAS u32x4*)(ldst2 + r * (16 * SP_PITCH)) = v; }
        }
        LDS_WAIT();
        f32x4 s[2];
#pragma unroll
        for (int tt = 0; tt < 2; ++tt) { s[tt] = (f32x4){0.f, 0.f, 0.f, 0.f};
            const LAS unsigned char* kr = buf + (16 * tt + fr) * SP_PITCH + g * 16;
#pragma unroll
            for (int ks = 0; ks < 9; ++ks) { const bf16x8 a = *(const LAS bf16x8*)(kr + ks * 64); s[tt] = __builtin_amdgcn_mfma_f32_16x16x32_bf16(a, qf[ks], s[tt], 0, 0, 0); } }
        float mx = -INFINITY;
#pragma unroll
        for (int tt = 0; tt < 2; ++tt)
#pragma unroll
            for (int e = 0; e < 4; ++e) { const int j = ch * 32 + 16 * tt + 4 * g + e; s[tt][e] = (j < nvalid) ? s[tt][e] * CSCALE2 : -INFINITY; mx = fmaxf(mx, s[tt][e]); }
        mx = fmaxf(mx, __shfl_xor(mx, 16)); mx = fmaxf(mx, __shfl_xor(mx, 32));
        const float mnew = fmaxf(mrun, mx), alpha = __builtin_amdgcn_exp2f(mrun - mnew);
        float ps = 0.f;
#pragma unroll
        for (int tt = 0; tt < 2; ++tt)
#pragma unroll
            for (int e = 0; e < 4; ++e) { s[tt][e] = __builtin_amdgcn_exp2f(s[tt][e] - mnew); ps += s[tt][e]; }
        ps += __shfl_xor(ps, 16); ps += __shfl_xor(ps, 32);
        lrun = lrun * alpha + ps; mrun = mnew;
        u32x4 pw; pw.x = pk2(s[0][0], s[0][1]); pw.y = pk2(s[0][2], s[0][3]); pw.z = pk2(s[1][0], s[1][1]); pw.w = pk2(s[1][2], s[1][3]);
        const bf16x8 pf = __builtin_bit_cast(bf16x8, pw);
        const LAS unsigned char* vb = buf + (4 * g + (fr >> 2)) * SP_PITCH + (fr & 3) * 8;
#pragma unroll
        for (int mt = 0; mt < 16; ++mt) {
            const bf16x8 vf = tr8(vb + mt * 32, vb + 16 * SP_PITCH + mt * 32);
            oacc[mt] = oacc[mt] * alpha;
            oacc[mt] = __builtin_amdgcn_mfma_f32_16x16x32_bf16(vf, pf, oacc[mt], 0, 0, 0);
        }
        LDS_WAIT();
    }
    const float inv = 1.0f / lrun;
#pragma unroll
    for (int mt = 0; mt < 16; ++mt) { u32x2 w; w.x = pk2(oacc[mt][0] * inv, oacc[mt][1] * inv); w.y = pk2(oacc[mt][2] * inv, oacc[mt][3] * inv);
        *(u32x2*)(qrow + fr * 288 + 16 * mt + 4 * g) = w; }
}

__global__ void __launch_bounds__(NTHREADS, 2) mega_fwd(Args args) {
    extern __shared__ __attribute__((aligned(16))) unsigned char lds_raw[];
    LAS unsigned char* lds = (LAS unsigned char*)lds_raw;
    cg::grid_group grid = cg::this_grid();
    const int wid = __builtin_amdgcn_readfirstlane((int)threadIdx.x >> 6);
#define PH_IDS int lane; asm volatile("v_mbcnt_lo_u32_b32 %0, -1, 0\n\tv_mbcnt_hi_u32_b32 %0, -1, %0" : "=&v"(lane)); const int tid = wid * 64 + lane; const int gt = bx * NTHREADS + tid; (void)gt; (void)tid; const __attribute__((address_space(4))) Args* ap_ = (const __attribute__((address_space(4))) Args*)__builtin_amdgcn_kernarg_segment_ptr(); asm volatile("" : "+s"(ap_))
    const int G = gridDim.x, bx = blockIdx.x;
    const int vcu = (G % 8 == 0) ? (bx % 8) * (G / 8) + bx / 8 : bx;
    const int gw = vcu * NWAVES + wid, NGW = G * NWAVES;
    const int NGT = G * NTHREADS;
#define ws (ap_->WSF)
#define out (ap_->OUTF)
#define X_IN (ap_->in[0])
#define p_in (ap_->in[1])
#define g_mix_pre (ap_->in[2])
#define g_mix_post (ap_->in[3])
#define g_mlp_pre (ap_->in[4])
#define g_mlp_post (ap_->in[5])
#define XN ((bf16_t*)(ws + WS_XN))
#define QKV ((bf16_t*)(ws + WS_QKV))
#define CS64 ((const f32x2*)(ws + WS_CS64))
#define CS32 ((const f32x2*)(ws + WS_CS32))
    const int lo = args.ph_lo, hi = args.ph_hi;
#ifndef PHMASK
#define PHMASK 0xFFFFFFFFu
#endif
#define IN(k) ((((PHMASK) >> (k)) & 1u) && lo <= (k) && (k) < hi)
#define LANE_NOW(v) asm volatile("v_mbcnt_lo_u32_b32 %0, -1, 0\n\tv_mbcnt_hi_u32_b32 %0, -1, %0" : "=&v"(v))
#define SEAM(k) do { if (IN(k) && IN((k) + 1)) { if ((k) == 0) grid.sync(); else { int l_; LANE_NOW(l_); xcd_barrier(xbar, wid == 0 && l_ == 0); } } } while (0)
    LAS unsigned* MISC = (LAS unsigned*)(lds + LDS_BYTES - 64);
    XcdBarrier xbar;
    { int l_; LANE_NOW(l_); if (wid == 0 && l_ < 16) MISC[l_] = 0u; __syncthreads();
      xbar = xcd_barrier_post((unsigned*)args.WSF + 1024, (volatile LAS unsigned*)(MISC + 8), wid == 0 && l_ == 0); }

#define LAYER_TAIL(LY, PT_) do { \
        if (IN((PT_) + 0)) { PH_IDS; \
            const float* resid = (LY) == 0 ? X_IN : out; const float* Ymix = (const float*)(ws + ((LY) == 0 ? WS_Y0 : WS_Y1)); \
            for (int m = gw; m < M; m += NGW) post_row<true>(Ymix + (size_t)m * 1024, resid + (size_t)m * 1024, out + (size_t)m * 1024, g_mix_post + (LY) * 1024, g_mlp_pre + (LY) * 1024, XN + (size_t)m * 1024, lane); \
        } \
        SEAM((PT_) + 0); \
        if (IN((PT_) + 1)) { PH_IDS; \
            pg8::Gemm gm{XN, (const bf16_t*)(ws + WS_WMI + (LY) * 8 * MiB), M, DFF, 1024}; pg8::StaticOrder S; S.init(M, DFF, G, bx); \
            pg8::EpiBf16<1> E{(bf16_t*)(ws + WS_HID), DFF, nullptr, 0, 0, 1.f}; \
            pg8::gemm_phase<pg8::EpiBf16<1>, pg8::StaticOrder, true, true>(lds, gm, S, E); \
        } \
        SEAM((PT_) + 1); \
        if (IN((PT_) + 2)) { PH_IDS; \
            pg8::Gemm gm{(const bf16_t*)(ws + WS_HID), (const bf16_t*)(ws + WS_WMO + (LY) * 8 * MiB), M, 1024, DFF}; pg8::StaticOrder S; S.init(M, 1024, G, bx); \
            pg8::EpiF32 E{(float*)(ws + WS_Y2), 1024}; \
            pg8::gemm_phase<pg8::EpiF32, pg8::StaticOrder, true, true>(lds, gm, S, E); \
        } \
        SEAM((PT_) + 2); \
        if (IN((PT_) + 3)) { PH_IDS; \
            const float* Y2 = (const float*)(ws + WS_Y2); bf16_t* PBF = (bf16_t*)(ws + WS_PBF); const float* pl = p_in + (size_t)(LY) * M * 256; \
            for (int m = gw; m < M; m += NGW) { \
                post_row<false>(Y2 + (size_t)m * 1024, out + (size_t)m * 1024, out + (size_t)m * 1024, g_mlp_post + (LY) * 1024, nullptr, XN + (size_t)m * 1024, lane); \
                const f32x4 pv = *((const f32x4*)(pl + (size_t)m * 256) + lane); u32x2 w; w.x = pk2(pv.x, pv.y); w.y = pk2(pv.z, pv.w); *((u32x2*)(PBF + (size_t)m * 256) + lane) = w; } \
        } \
        SEAM((PT_) + 3); \
        if (IN((PT_) + 4)) { PH_IDS; \
            { pg8::Gemm gm{(const bf16_t*)(ws + WS_PBF), (const bf16_t*)(ws + WS_WPP + (LY) * 512 * 1024), M, 1024, 256}; pg8::StaticOrder S; S.init(M, 1024, G, bx); \
              pg8::EpiF32 E{(float*)(ws + WS_PLE), 1024}; \
              pg8::gemm_phase<pg8::EpiF32, pg8::StaticOrder, true, true>(lds, gm, S, E); } \
            VM_WAIT(); __syncthreads(); \
            { pg8::Gemm gm{XN, (const bf16_t*)(ws + WS_WPG + (LY) * 2 * MiB), M, 1024, 1024}; pg8::StaticOrder S; S.init(M, 1024, G, bx); \
              pg8::EpiGate E{out, (const float*)(ws + WS_PLE), 1024}; \
              pg8::gemm_phase<pg8::EpiGate, pg8::StaticOrder, true, true>(lds, gm, S, E); } \
        } \
        if ((LY) == 0) SEAM((PT_) + 4); \
    } while (0)
    if (IN(0)) { PH_IDS;
        LAS float* scr = (LAS float*)(lds + wid * 16384);
#define TJOB(Wp, K_, N_, dst_) do { const float* W_ = (Wp); const int nit_ = ((K_) / 64) * ((N_) / 32); \
            for (int it = gw; it < nit_; it += NGW) transpose_item(W_, (K_), (N_), (bf16_t*)(ws + (dst_)), scr, it, lane); } while (0)
        TJOB(ap_->in[10], 1024, 3072, WS_WAB); TJOB(ap_->in[11], 1024, 1024, WS_WOAB);
        TJOB(ap_->in[6], 1024, 4096, WS_WMI); TJOB(ap_->in[6] + (size_t)1024 * 4096, 1024, 4096, WS_WMI + 8 * MiB);
        TJOB(ap_->in[7], 4096, 1024, WS_WMO); TJOB(ap_->in[7] + (size_t)4096 * 1024, 4096, 1024, WS_WMO + 8 * MiB);
        TJOB(ap_->in[8], 256, 1024, WS_WPP); TJOB(ap_->in[8] + (size_t)256 * 1024, 256, 1024, WS_WPP + 512 * 1024);
        TJOB(ap_->in[9], 1024, 1024, WS_WPG); TJOB(ap_->in[9] + (size_t)1024 * 1024, 1024, 1024, WS_WPG + 2 * MiB);
        TJOB(ap_->in[21], 384, 512, WS_WQI);
#undef TJOB
        {
            const float* W = ap_->in[17]; bf16_t* WT = (bf16_t*)(ws + WS_WC);
            for (int e = gt; e < 768 * 1024; e += NGT) { const int n = e >> 10, k = e & 1023; WT[e] = (bf16_t)(n < 744 ? f2bf(W[(size_t)k * 744 + n]) : 0u); }
        }
        {
            const float* wuq = ap_->in[20]; const float* wuk = ap_->in[22]; bf16_t* WT = (bf16_t*)(ws + WS_WQF);
            for (int e = gt; e < 4608 * 384; e += NGT) { const int n = e / 384, k = e - n * 384, hh = n / 288, j = n - hh * 288; float acc;
                if (j < 256) { const f32x4* a = (const f32x4*)(wuq + (size_t)k * 1536 + hh * 96); const f32x4* bq = (const f32x4*)(wuk + ((size_t)j * 16 + hh) * 64); acc = 0.f;
#pragma unroll
                    for (int d = 0; d < 16; ++d) { const f32x4 av = a[d], bv = bq[d]; acc += (av.x * bv.x + av.y * bv.y) + (av.z * bv.z + av.w * bv.w); } }
                else acc = wuq[(size_t)k * 1536 + hh * 96 + 64 + (j - 256)];
                WT[e] = (bf16_t)f2bf(acc); }
        }
        {
            const float* wuv = ap_->in[23]; const float* woc = ap_->in[24]; bf16_t* WT = (bf16_t*)(ws + WS_WCOMB);
            for (int e = gt; e < 1024 * 4608; e += NGT) { const int n = e / 4608, kk = e - n * 4608, hh = kk / 288, c = kk - hh * 288; float acc = 0.f;
                if (c < 256) { const float* a = wuv + ((size_t)c * 16 + hh) * 64; const float* bq = woc + (size_t)(hh * 64) * 1024 + n;
#pragma unroll 8
                    for (int d = 0; d < 64; ++d) acc += a[d] * bq[(size_t)d * 1024]; }
                WT[e] = (bf16_t)f2bf(acc); }
        }
        {
            f32x2* c64 = (f32x2*)(ws + WS_CS64); f32x2* c32 = (f32x2*)(ws + WS_CS32);
            for (int e = gt; e < 4096 * 48; e += NGT) { int pos, i, half; f32x2* dstp;
                if (e < 4096 * 32) { pos = e >> 5; i = e & 31; half = 32; dstp = c64 + e; } else { const int e2 = e - 4096 * 32; pos = e2 >> 4; i = e2 & 15; half = 16; dstp = c32 + e2; }
                const double inv = exp(-(double)i / (double)half * 9.210340371976184);
                const double rev = (double)pos * inv * 0.15915494309189535;
                const float fr = (float)(rev - floor(rev));
                *dstp = (f32x2){__builtin_amdgcn_cosf(fr), __builtin_amdgcn_sinf(fr)}; }
        }
        for (int m = gw; m < M; m += NGW) rms_row_to_bf16(X_IN + (size_t)m * 1024, g_mix_pre, XN + (size_t)m * 1024, lane);
    }
    SEAM(0);

    {
        {
            constexpr int PB = 1;
            if (IN(PB + 0)) { PH_IDS;
                pg8::Gemm gm{XN, (const bf16_t*)(ws + WS_WAB), M, 3072, 1024}; pg8::StaticOrder S; S.init(M, 3072, G, bx);
                pg8::EpiBf16<0> E{QKV, 3072, nullptr, 0, 0, 1.f};
                pg8::gemm_phase<pg8::EpiBf16<0>, pg8::StaticOrder, true, true>(lds, gm, S, E);
            }
            SEAM(PB + 0);
            if (IN(PB + 1)) { PH_IDS;
                for (int m = gw; m < M; m += NGW) { const int pos = m & (SEQ - 1); bf16_t* row = QKV + (size_t)m * 3072;
#pragma unroll
                    for (int j = 0; j < 4; ++j) { const int id = j * 64 + lane, hx = id >> 3, grp = id & 7, reg = hx >> 3;
                        const int cb = (reg == 0 ? 0 : (reg == 1 ? 512 : (reg == 2 ? 1536 : 2048))) + (hx & 7) * 64 + 4 * grp;
                        const float sc = (reg == 0 || reg == 2) ? QSCALE : 1.0f;
                        const u32x2 a = *(const u32x2*)(row + cb), bq = *(const u32x2*)(row + cb + 32);
                        const f32x2* cs = CS64 + (size_t)pos * 32 + 4 * grp;
                        const f32x2 c0 = cs[0], c1 = cs[1], c2 = cs[2], c3 = cs[3];
                        const float x10 = bflo(a.x), x11 = bfhi(a.x), x12 = bflo(a.y), x13 = bfhi(a.y), x20 = bflo(bq.x), x21 = bfhi(bq.x), x22 = bflo(bq.y), x23 = bfhi(bq.y);
                        u32x2 o1, o2;
                        o1.x = pk2((x10 * c0.x - x20 * c0.y) * sc, (x11 * c1.x - x21 * c1.y) * sc); o1.y = pk2((x12 * c2.x - x22 * c2.y) * sc, (x13 * c3.x - x23 * c3.y) * sc);
                        o2.x = pk2((x10 * c0.y + x20 * c0.x) * sc, (x11 * c1.y + x21 * c1.x) * sc); o2.y = pk2((x12 * c2.y + x22 * c2.x) * sc, (x13 * c3.y + x23 * c3.x) * sc);
                        *(u32x2*)(row + cb) = o1; *(u32x2*)(row + cb + 32) = o2; } }
            }
            SEAM(PB + 1);
            if (IN(PB + 2)) { PH_IDS;
                const attn_body::AttnTensors AT{(const attn_body::bf16*)QKV, (const attn_body::bf16*)QKV, (const attn_body::bf16*)QKV, (attn_body::bf16*)(ws + WS_OA)};
                const attn_body::StaticOrder S(vcu);
#ifndef NO_ATTN
                attn_body::attn_phase<attn_body::StaticOrder>((char*)lds_raw, AT, S);
                __syncthreads();
#endif
                bf16_t* OB = (bf16_t*)out; float* LSE = (float*)((unsigned char*)out + OUT_LSE_OFF);
#ifndef NO_DIL
                { int lane2; asm volatile("v_mbcnt_lo_u32_b32 %0, -1, 0\n\tv_mbcnt_hi_u32_b32 %0, -1, %0" : "=&v"(lane2)); const int tid2 = wid * 64 + lane2;
#pragma unroll 1
                for (int i = 0; i < 24; ++i) dilated_unit(vcu * 24 + i, QKV, OB, LSE, lds, tid2, wid, lane2); }
#endif
            }
            SEAM(PB + 2);
            if (IN(PB + 3)) { PH_IDS;
                const float lam_init = 0.2f;
                const float d1 = wave_sum(ap_->in[12][lane] * ap_->in[13][lane]), d2 = wave_sum(ap_->in[14][lane] * ap_->in[15][lane]);
                const float lam = __expf(d1) - __expf(d2) + lam_init;
                const bf16_t* OA = (const bf16_t*)(ws + WS_OA); const bf16_t* OB = (const bf16_t*)out; const float* LSE = (const float*)((const unsigned char*)out + OUT_LSE_OFF);
                bf16_t* CAT = (bf16_t*)(ws + WS_CAT);
                const f32x4 gs = *((const f32x4*)ap_->in[16] + (lane & 31));
                for (int m = gw; m < M; m += NGW) {
                    const bf16_t* oa = OA + (size_t)m * 1024; bf16_t* ct = CAT + (size_t)m * 1024;
#pragma unroll
                    for (int hh = 0; hh < 4; ++hh) {
                        const u32x2 w = *(const u32x2*)(oa + hh * 256 + 4 * lane);
                        f32x4 v = (f32x4){bflo(w.x), bfhi(w.x), bflo(w.y), bfhi(w.y)};
                        f32x4 o; o.x = __shfl_xor(v.x, 32); o.y = __shfl_xor(v.y, 32); o.z = __shfl_xor(v.z, 32); o.w = __shfl_xor(v.w, 32);
                        const f32x4 dfv = (lane < 32) ? (v - lam * o) : (o - lam * v);
                        const float ss = half_sum((dfv.x * dfv.x + dfv.y * dfv.y) + (dfv.z * dfv.z + dfv.w * dfv.w));
                        const float rr = rsqrtf(ss * (1.f / 128.f) + EPS) * (1.0f - lam_init);
                        const f32x4 r = dfv * rr * gs;
                        if (lane < 32) { u32x2 ow; ow.x = pk2(r.x, r.y); ow.y = pk2(r.z, r.w); *(u32x2*)(ct + hh * 128 + 4 * lane) = ow; }
                    }
                    {
                        const int hh = lane >> 3;
                        const float l0 = LSE[((size_t)0 * M + m) * 8 + hh], l1 = LSE[((size_t)1 * M + m) * 8 + hh], l2 = LSE[((size_t)2 * M + m) * 8 + hh];
                        const float mx = fmaxf(l0, fmaxf(l1, l2)); float w0 = __expf(l0 - mx), w1 = __expf(l1 - mx), w2 = __expf(l2 - mx); const float iw = 1.0f / (w0 + w1 + w2); w0 *= iw; w1 *= iw; w2 *= iw;
                        const u32x4 a0 = *(const u32x4*)(OB + ((size_t)0 * M + m) * 512 + 8 * lane), a1 = *(const u32x4*)(OB + ((size_t)1 * M + m) * 512 + 8 * lane), a2 = *(const u32x4*)(OB + ((size_t)2 * M + m) * 512 + 8 * lane);
                        u32x4 o;
#pragma unroll
                        for (int e = 0; e < 4; ++e) o[e] = pk2(w0 * bflo(a0[e]) + w1 * bflo(a1[e]) + w2 * bflo(a2[e]), w0 * bfhi(a0[e]) + w1 * bfhi(a1[e]) + w2 * bfhi(a2[e]));
                        *(u32x4*)(ct + 512 + 8 * lane) = o;
                    }
                }
            }
            SEAM(PB + 3);
            if (IN(PB + 4)) { PH_IDS;
                pg8::Gemm gm{(const bf16_t*)(ws + WS_CAT), (const bf16_t*)(ws + WS_WOAB), M, 1024, 1024}; pg8::StaticOrder S; S.init(M, 1024, G, bx);
                pg8::EpiF32 E{(float*)(ws + WS_Y0), 1024};
                pg8::gemm_phase<pg8::EpiF32, pg8::StaticOrder, true, true>(lds, gm, S, E);
            }
            SEAM(PB + 4);
        }
        LAYER_TAIL(0, 6);
        {
            constexpr int PB = 11;
            if (IN(PB + 0)) { PH_IDS;
                for (int m = gw; m < M; m += NGW) rms_row_to_bf16(out + (size_t)m * 1024, g_mix_pre + 1024, XN + (size_t)m * 1024, lane);
            }
            SEAM(PB + 0);
            if (IN(PB + 1)) { PH_IDS;
                pg8::Gemm gm{XN, (const bf16_t*)(ws + WS_WC), M, 768, 1024}; pg8::StaticOrder S; S.init(M, 768, G, bx);
                pg8::EpiF32 E{(float*)(ws + WS_CIN), 768};
                pg8::gemm_phase<pg8::EpiF32, pg8::StaticOrder, true, true>(lds, gm, S, E);
            }
            SEAM(PB + 1);
            if (IN(PB + 2)) { PH_IDS;
                const float* CIN = (const float*)(ws + WS_CIN); bf16_t* CQN = (bf16_t*)(ws + WS_CQN); bf16_t* KV = (bf16_t*)(ws + WS_KV); bf16_t* KI = (bf16_t*)(ws + WS_KI); float* WI = (float*)(ws + WS_WI);
                const float* gcq = ap_->in[18]; const float* gckv = ap_->in[19];
                for (int m = gw; m < M; m += NGW) { const float* r = CIN + (size_t)m * 768; const int pos = m & (SEQ - 1);
                    f32x2 a[3]; float s = 0.f;
#pragma unroll
                    for (int j = 0; j < 3; ++j) { a[j] = *(const f32x2*)(r + 2 * lane + 128 * j); s += a[j].x * a[j].x + a[j].y * a[j].y; }
                    const float r1 = rsqrtf(wave_sum(s) * (1.f / 384.f) + EPS);
#pragma unroll
                    for (int j = 0; j < 3; ++j) { const f32x2 gg = *(const f32x2*)(gcq + 2 * lane + 128 * j); *(unsigned*)(CQN + (size_t)m * 384 + 2 * lane + 128 * j) = pk2(a[j].x * r1 * gg.x, a[j].y * r1 * gg.y); }
                    const f32x4 kvv = *(const f32x4*)(r + 384 + 4 * lane);
                    const float r2 = rsqrtf(wave_sum((kvv.x * kvv.x + kvv.y * kvv.y) + (kvv.z * kvv.z + kvv.w * kvv.w)) * (1.f / 256.f) + EPS);
                    const f32x4 g2 = *(const f32x4*)(gckv + 4 * lane);
                    { u32x2 w; w.x = pk2(kvv.x * r2 * g2.x, kvv.y * r2 * g2.y); w.y = pk2(kvv.z * r2 * g2.z, kvv.w * r2 * g2.w); *(u32x2*)(KV + (size_t)m * 288 + 4 * lane) = w; }
                    if (lane < 16) { const f32x2 c = CS32[(size_t)pos * 16 + lane]; const float x1 = r[640 + lane], x2 = r[656 + lane];
                        KV[(size_t)m * 288 + 256 + lane] = (bf16_t)f2bf(x1 * c.x - x2 * c.y); KV[(size_t)m * 288 + 272 + lane] = (bf16_t)f2bf(x1 * c.y + x2 * c.x); }
                    else if (lane < 32) { const int i = lane - 16; const f32x2 c = CS32[(size_t)pos * 16 + i]; const float x1 = r[672 + i], x2 = r[688 + i];
                        KI[(size_t)m * 64 + i] = (bf16_t)f2bf(x1 * c.x - x2 * c.y); KI[(size_t)m * 64 + 16 + i] = (bf16_t)f2bf(x1 * c.y + x2 * c.x); }
                    else { const int i = lane - 32; KI[(size_t)m * 64 + 32 + i] = (bf16_t)f2bf(r[704 + i]); }
                    if (lane < 8) WI[(size_t)m * 8 + lane] = r[736 + lane] * (0.35355339059327373f * 0.125f);
                }
            }
            SEAM(PB + 2);
            if (IN(PB + 3)) { PH_IDS;
                pg8::Gemm gm{(const bf16_t*)(ws + WS_CQN), (const bf16_t*)(ws + WS_WQI), M, 512, 384}; pg8::StaticOrder S; S.init(M, 512, G, bx);
                pg8::EpiBf16<0> E{(bf16_t*)(ws + WS_QI), 512, nullptr, 0, 0, 1.f};
                pg8::gemm_phase<pg8::EpiBf16<0>, pg8::StaticOrder, true, true>(lds, gm, S, E);
            }
            SEAM(PB + 3);
            if (IN(PB + 4)) { PH_IDS;
                float* scr = (float*)(ws + WS_SCR) + (size_t)gw * (4 * 4096);
                for (int j = 0; j < 4; ++j) { const int b = 2 * j + (gw >> 10), q4 = (j & 1) ? 1023 - (gw & 1023) : (gw & 1023);
                    indexer_unit(b, q4, (const bf16_t*)(ws + WS_QI), (const bf16_t*)(ws + WS_KI), (const float*)(ws + WS_WI), CS32, scr, (int*)(ws + WS_IDX), lane);
                    VM_WAIT(); }
            }
            SEAM(PB + 4);
            if (IN(PB + 5)) { PH_IDS;
                pg8::Gemm gm{(const bf16_t*)(ws + WS_CQN), (const bf16_t*)(ws + WS_WQF), M, CQ, 384}; pg8::StaticOrder S; S.init(M, CQ, G, bx);
                pg8::EpiBf16<0> E{(bf16_t*)(ws + WS_QF), CQ, nullptr, 0, 0, 1.f};
                pg8::gemm_phase<pg8::EpiBf16<0>, pg8::StaticOrder, true, true>(lds, gm, S, E);
            }
            SEAM(PB + 5);
            if (IN(PB + 6)) { PH_IDS;
                bf16_t* QF = (bf16_t*)(ws + WS_QF);
                for (int m = gw; m < M; m += NGW) { const int pos = m & (SEQ - 1); bf16_t* row = QF + (size_t)m * CQ;
#pragma unroll
                    for (int j = 0; j < 4; ++j) { const int id = j * 64 + lane, hh = id >> 4, i = id & 15; const f32x2 c = CS32[(size_t)pos * 16 + i];
                        bf16_t* pp = row + hh * 288 + 256 + i; const float x1 = bf2f(pp[0]), x2 = bf2f(pp[16]);
                        pp[0] = (bf16_t)f2bf(x1 * c.x - x2 * c.y); pp[16] = (bf16_t)f2bf(x1 * c.y + x2 * c.x); } }
            }
            SEAM(PB + 6);
            if (IN(PB + 7)) { PH_IDS;
                bf16_t* QF = (bf16_t*)(ws + WS_QF); const bf16_t* KV = (const bf16_t*)(ws + WS_KV); const int* IDX = (const int*)(ws + WS_IDX);
                LAS unsigned char* buf = lds + wid * SP_BUF;
                for (int m = gw; m < M; m += NGW) { const int t = m & (SEQ - 1), b = m >> 12;
                    sparse_query(QF + (size_t)m * CQ, KV + (size_t)b * SEQ * 288, IDX + (size_t)m * 256, t + 1 < 256 ? t + 1 : 256, buf, lane); }
            }
            SEAM(PB + 7);
            if (IN(PB + 8)) { PH_IDS;
                pg8::Gemm gm{(const bf16_t*)(ws + WS_QF), (const bf16_t*)(ws + WS_WCOMB), M, 1024, CQ}; pg8::StaticOrder S; S.init(M, 1024, G, bx);
                pg8::EpiF32 E{(float*)(ws + WS_Y1), 1024};
                pg8::gemm_phase<pg8::EpiF32, pg8::StaticOrder, true, true>(lds, gm, S, E);
            }
            SEAM(PB + 8);
        }
        LAYER_TAIL(1, 20);
    }
#undef IN
#undef SEAM
#undef LAYER_TAIL
#undef ws
#undef out
#undef X_IN
#undef p_in
#undef g_mix_pre
#undef g_mix_post
#undef g_mlp_pre
#undef g_mlp_post
#undef XN
#undef QKV
#undef CS64
#undef CS32
}
}

extern "C" void kernel_launch(void* const* d_in, const int* in_sizes, int n_in, void* d_out, int out_size, void* d_ws, size_t ws_size, hipStream_t stream) {
    static int grid = 0;
    if (grid == 0) {
        if (n_in != 25 || out_size != mk::M * 1024 || ws_size < mk::WS_END) { fprintf(stderr, "kernel_launch: unexpected shapes (n_in %d, out %d, ws %zu)\n", n_in, out_size, ws_size); grid = -1; return; }
        int dev = 0, cus = 0, per_cu = 0;
        hipGetDevice(&dev); hipDeviceGetAttribute(&cus, hipDeviceAttributeMultiprocessorCount, dev);
        if (hipFuncSetAttribute((const void*)mk::mega_fwd, hipFuncAttributeMaxDynamicSharedMemorySize, mk::LDS_BYTES) != hipSuccess) { fprintf(stderr, "kernel_launch: hipFuncSetAttribute failed\n"); grid = -1; return; }
        if (hipOccupancyMaxActiveBlocksPerMultiprocessor(&per_cu, (const void*)mk::mega_fwd, mk::NTHREADS, mk::LDS_BYTES) != hipSuccess || per_cu < 1) { fprintf(stderr, "kernel_launch: occupancy query gives %d\n", per_cu); per_cu = 1; (void)hipGetLastError(); }
        grid = cus;
        fprintf(stderr, "kernel_launch: grid %d (occupancy %d per CU)\n", grid, per_cu);
    }
    if (grid < 0) return;
    if (hipMemsetAsync(d_ws, 0, 65536, stream) != hipSuccess) { fprintf(stderr, "kernel_launch: hipMemsetAsync failed\n"); return; }
    mk::Args a{};
    for (int i = 0; i < 25; ++i) a.in[i] = (const float*)d_in[i];
    a.OUTF = (float*)d_out; a.WSF = (unsigned char*)d_ws; a.ph_lo = 0; a.ph_hi = 1000;
    void* kargs[] = {&a};
    const hipError_t e = hipLaunchCooperativeKernel((const void*)mk::mega_fwd, dim3(grid), dim3(mk::NTHREADS), kargs, mk::LDS_BYTES, stream);
    if (e != hipSuccess) fprintf(stderr, "kernel_launch: cooperative launch failed: %s (grid %d)\n", hipGetErrorString(e), grid);
}
```
